# Optimizing an MI355X kernel written in HIP

```python
import math
import jax
import jax.numpy as jnp
from jax import lax
import numpy as np

D_MODEL = 1024
BATCH = 16
SEQ = 4096
DEPTH = 4

GRID_W = 64
CTX_LEN = 256
D_RG = 1024
RG_HEADS = 16
RG_HEAD_DIM = D_RG // RG_HEADS
RG_CONV = 4
RG_PAD_L = 1
RG_PAD_R = 2
RG_C = 8.0
D_HG = 1024
HG_EXPAND = 128
HG_HEADS = D_HG // HG_EXPAND
HG_VDIM = D_HG // HG_HEADS
HG_CHUNK = 32
D_FF = 2816
FFN_CONV = 3
N_MOD = 6
EPS = 1e-6
O_RGX = 0
O_RGG = O_RGX + D_RG
O_HG = O_RGG + D_RG
O_GA = O_HG + 5 * D_HG
O_GB = O_GA + D_MODEL
IN_WIDTH = O_GB + D_MODEL

kernel_name = 'hybrid_rglru_hgrn2_convffn_prefix_dit'


def rms_norm(x, g):
    x32 = x.astype(jnp.float32)
    y = x32 * lax.rsqrt(jnp.mean(x32 * x32, axis=-1, keepdims=True) + EPS)
    return (y * g.astype(jnp.float32)).astype(x.dtype)


def dwconv(x, w, b, pad_l, pad_r):
    L = x.shape[1]
    xp = jnp.pad(x, ((0, 0), (pad_l, pad_r), (0, 0)))
    return b + sum(xp[:, j:j + L] * w[j] for j in range(w.shape[0]))


def to_col(t, rows):
    B, L = t.shape[:2]
    return t.reshape(B, rows, GRID_W, *t.shape[2:]).swapaxes(1, 2).reshape(B, L, *t.shape[2:])


def from_col(t, rows):
    B, L = t.shape[:2]
    return t.reshape(B, GRID_W, rows, *t.shape[2:]).swapaxes(1, 2).reshape(B, L, *t.shape[2:])


def linear_scan(a, b, h0, reverse):
    if reverse:
        a, b = jnp.flip(a, 1), jnp.flip(b, 1)
    comb = lambda l, r: (l[0] * r[0], r[0] * l[1] + r[1])
    A, Bc = lax.associative_scan(comb, (a, b), axis=1)
    h = A * h0[:, None] + Bc
    final = h[:, -1]
    if reverse:
        h = jnp.flip(h, 1)
    return h, final


def rglru_coeffs(x, wa, ba, wx, bx, lam):
    B, L, _ = x.shape
    xh = x.reshape(B, L, RG_HEADS, RG_HEAD_DIM)
    r = jax.nn.sigmoid(jnp.einsum('blhi,hij->blhj', xh, wa).reshape(B, L, D_RG) + ba)
    i = jax.nn.sigmoid(jnp.einsum('blhi,hij->blhj', xh, wx).reshape(B, L, D_RG) + bx)
    log_a = -RG_C * jax.nn.softplus(-lam) * r
    a = jnp.exp(log_a)
    b = jnp.sqrt(-jnp.expm1(2.0 * log_a)) * (i * x)
    return a, b


def hgrn2_scan(q, logf, k, v, s0):
    B, L = q.shape[:2]
    n = L // HG_CHUNK
    chunks = lambda t: t.reshape(B, n, HG_CHUNK, *t.shape[2:]).swapaxes(0, 1)
    tri = jnp.tril(jnp.ones((HG_CHUNK, HG_CHUNK), dtype=bool))[None, :, :, None, None]

    def step(S, inp):
        qc, gc, kc, vc = inp
        bcum = jnp.cumsum(gc, axis=1)
        o_inter = jnp.einsum('bchk,bhkv->bchv', qc * jnp.exp(bcum), S)
        diff = bcum[:, :, None] - bcum[:, None, :]
        w = jnp.exp(jnp.where(tri, diff, -jnp.inf))
        A = jnp.einsum('bthk,btshk,bshk->bhts', qc, w, kc)
        o_intra = jnp.einsum('bhts,bshv->bthv', A, vc)
        blast = bcum[:, -1]
        S_new = jnp.exp(blast)[..., None] * S + jnp.einsum('bshk,bshv->bhkv', kc * jnp.exp(blast[:, None] - bcum), vc)
        return S_new.astype(S.dtype), o_inter + o_intra

    S_fin, o = lax.scan(step, s0, (chunks(q), chunks(logf), chunks(k), chunks(v)))
    return o.swapaxes(0, 1).reshape(B, L, HG_HEADS, HG_VDIM), S_fin


def hgrn2_dir(q, logf, k, v, s0, reverse):
    if reverse:
        q, logf, k, v = (jnp.flip(t, 1) for t in (q, logf, k, v))
    o, S = hgrn2_scan(q, logf, k, v, s0)
    if reverse:
        o = jnp.flip(o, 1)
    return o, S


def hg_features(zb, lb):
    B, L, _ = zb.shape
    hs = lambda t: t.reshape(B, L, HG_HEADS, HG_EXPAND)
    lb = lb.reshape(HG_HEADS, HG_EXPAND).astype(zb.dtype)
    q = hs(jax.nn.silu(zb[..., 0:D_HG]))
    dirs = []
    for j in (1, 2):
        zf = hs(zb[..., j * D_HG:(j + 1) * D_HG])
        logf = jnp.logaddexp(jnp.log(lb), jnp.log1p(-lb) + jax.nn.log_sigmoid(zf))
        k = (1.0 - lb) * jax.nn.sigmoid(-zf)
        dirs.append((logf, k))
    v = zb[..., 3 * D_HG:4 * D_HG].reshape(B, L, HG_HEADS, HG_VDIM)
    og = zb[..., 4 * D_HG:5 * D_HG]
    return q, dirs, v, og


def hg_out(o, og, gain):
    B, L = o.shape[:2]
    return rms_norm(o, gain.reshape(HG_HEADS, HG_VDIM)).reshape(B, L, D_HG) * jax.nn.silu(og)


def merge(z, r, y_hg, lp):
    y_rg = jax.nn.gelu(z[..., O_RGG:O_RGG + D_RG]) * r
    p_rg = y_rg @ lp['w_proj_rg']
    p_hg = y_hg @ lp['w_proj_hg']
    m = jax.nn.sigmoid(z[..., O_GA:O_GA + D_MODEL]) * p_rg + jax.nn.sigmoid(z[..., O_GB:O_GB + D_MODEL]) * p_hg
    return m @ lp['w_out']


def mixer(hc, hl, lp, lb, rows, need_ctx):
    B = hl.shape[0]
    zc = hc @ lp['w_in']
    zl = hl @ lp['w_in']
    xc = dwconv(zc[..., O_RGX:O_RGX + D_RG], lp['rg_conv_w'], lp['rg_conv_b'], RG_PAD_L, RG_PAD_R)
    xl = dwconv(zl[..., O_RGX:O_RGX + D_RG], lp['rg_conv_w'], lp['rg_conv_b'], RG_PAD_L, RG_PAD_R)
    rc, rl = 0.0, 0.0
    for d in range(2):
        prm = (lp['rg_wa'][d], lp['rg_ba'][d], lp['rg_wx'][d], lp['rg_bx'][d], lp['rg_lam'][d])
        rev = d == 1
        hcd, st = linear_scan(*rglru_coeffs(xc, *prm), jnp.zeros((B, D_RG), xc.dtype), rev)
        hld, _ = linear_scan(*rglru_coeffs(xl, *prm), st, rev)
        rc = rc + hcd
        rl = rl + hld
    qc, dirs_c, vc, ogc = hg_features(zc[..., O_HG:O_HG + 5 * D_HG], lb)
    ql, dirs_l, vl, ogl = hg_features(to_col(zl[..., O_HG:O_HG + 5 * D_HG], rows), lb)
    oc, ol = 0.0, 0.0
    for d in range(2):
        rev = d == 1
        s0 = jnp.zeros((B, HG_HEADS, HG_EXPAND, HG_VDIM), vc.dtype)
        ocd, st = hgrn2_dir(qc, dirs_c[d][0], dirs_c[d][1], vc, s0, rev)
        old, _ = hgrn2_dir(ql, dirs_l[d][0], dirs_l[d][1], vl, st, rev)
        oc = oc + ocd
        ol = ol + old
    yl = merge(zl, rl, from_col(hg_out(ol, ogl, lp['hg_out_norm']), rows), lp)
    yc = merge(zc, rc, hg_out(oc, ogc, lp['hg_out_norm']), lp) if need_ctx else None
    return yc, yl


def conv_ffn(h, w_up, cw, cb, w_down, rows):
    B, L, _ = h.shape
    u = h @ w_up
    g, v = u[..., :D_FF], u[..., D_FF:]
    if rows is None:
        g = dwconv(g, cw, cb, 1, 1)
    else:
        g = dwconv(g.reshape(B * rows, GRID_W, D_FF), cw, cb, 1, 1).reshape(B, L, D_FF)
    return (jax.nn.silu(g) * v) @ w_down


def setup_inputs(seed: int = 0) -> dict:
    key = jax.random.key(seed)
    ks = iter(jax.random.split(key, 40))
    f32 = jnp.float32
    nrm = lambda shape, fan_in: jax.random.normal(next(ks), shape, f32) * fan_in ** -0.5
    small = lambda shape: 0.01 * jax.random.normal(next(ks), shape, f32)
    gain = lambda shape: 1.0 + 0.02 * jax.random.normal(next(ks), shape, f32)
    x = jax.random.normal(next(ks), (BATCH, SEQ, D_MODEL), f32)
    c = jax.random.normal(next(ks), (BATCH, D_MODEL), f32)
    ctx = jax.random.normal(next(ks), (BATCH, CTX_LEN, D_MODEL), f32)
    c_ctx = jax.random.normal(next(ks), (D_MODEL,), f32)
    w_ada = 0.5 * nrm((DEPTH, D_MODEL, N_MOD * D_MODEL), D_MODEL)
    b_ada = small((DEPTH, N_MOD * D_MODEL))
    g_pre_mix = gain((DEPTH, D_MODEL))
    g_post_mix = gain((DEPTH, D_MODEL))
    g_pre_ffn = gain((DEPTH, D_MODEL))
    g_post_ffn = gain((DEPTH, D_MODEL))
    w_in = nrm((DEPTH, D_MODEL, IN_WIDTH), D_MODEL)
    rg_conv_w = nrm((DEPTH, RG_CONV, D_RG), RG_CONV)
    rg_conv_b = small((DEPTH, D_RG))
    rg_wa = nrm((DEPTH, 2, RG_HEADS, RG_HEAD_DIM, RG_HEAD_DIM), RG_HEAD_DIM)
    rg_ba = small((DEPTH, 2, D_RG))
    rg_wx = nrm((DEPTH, 2, RG_HEADS, RG_HEAD_DIM, RG_HEAD_DIM), RG_HEAD_DIM)
    rg_bx = small((DEPTH, 2, D_RG))
    u = jax.random.uniform(next(ks), (DEPTH, 2, D_RG), f32, minval=0.9, maxval=0.999)
    a0 = u ** (1.0 / RG_C)
    rg_lam = jnp.log(a0) - jnp.log1p(-a0)
    hg_lb_logits = 0.1 * jax.random.normal(next(ks), (DEPTH, D_HG), f32)
    hg_out_norm = gain((DEPTH, D_HG))
    w_proj_rg = nrm((DEPTH, D_RG, D_MODEL), D_RG)
    w_proj_hg = nrm((DEPTH, D_HG, D_MODEL), D_HG)
    w_out = nrm((DEPTH, D_MODEL, D_MODEL), D_MODEL)
    ffn_w_up = nrm((DEPTH, D_MODEL, 2 * D_FF), D_MODEL)
    ffn_conv_w = nrm((DEPTH, FFN_CONV, D_FF), FFN_CONV)
    ffn_conv_b = small((DEPTH, D_FF))
    ffn_w_down = nrm((DEPTH, D_FF, D_MODEL), D_FF)
    return {'x': x, 'c': c, 'ctx': ctx, 'c_ctx': c_ctx, 'w_ada': w_ada, 'b_ada': b_ada,
            'g_pre_mix': g_pre_mix, 'g_post_mix': g_post_mix, 'g_pre_ffn': g_pre_ffn, 'g_post_ffn': g_post_ffn,
            'w_in': w_in, 'rg_conv_w': rg_conv_w, 'rg_conv_b': rg_conv_b, 'rg_wa': rg_wa, 'rg_ba': rg_ba,
            'rg_wx': rg_wx, 'rg_bx': rg_bx, 'rg_lam': rg_lam, 'hg_lb_logits': hg_lb_logits,
            'hg_out_norm': hg_out_norm, 'w_proj_rg': w_proj_rg, 'w_proj_hg': w_proj_hg, 'w_out': w_out,
            'ffn_w_up': ffn_w_up, 'ffn_conv_w': ffn_conv_w, 'ffn_conv_b': ffn_conv_b, 'ffn_w_down': ffn_w_down}


def reference(x, c, ctx, c_ctx, w_ada, b_ada, g_pre_mix, g_post_mix, g_pre_ffn, g_post_ffn,
              w_in, rg_conv_w, rg_conv_b, rg_wa, rg_ba, rg_wx, rg_bx, rg_lam, hg_lb_logits,
              hg_out_norm, w_proj_rg, w_proj_hg, w_out, ffn_w_up, ffn_conv_w, ffn_conv_b, ffn_w_down):
    B, L, _ = x.shape
    rows = L // GRID_W
    p = jax.nn.softmax(hg_lb_logits.astype(jnp.float32), axis=0)
    cum = jnp.cumsum(p, axis=0)
    lb_all = cum - cum[0:1]
    sc = jax.nn.silu(c)
    scc = jax.nn.silu(c_ctx)
    xl, xc = x, ctx
    for l in range(DEPTH):
        need_ctx = l < DEPTH - 1
        ml = jnp.split((sc @ w_ada[l] + b_ada[l])[:, None, :], N_MOD, axis=-1)
        mc = jnp.split(scc @ w_ada[l] + b_ada[l], N_MOD, axis=-1)
        lp = dict(w_in=w_in[l], rg_conv_w=rg_conv_w[l], rg_conv_b=rg_conv_b[l], rg_wa=rg_wa[l],
                  rg_ba=rg_ba[l], rg_wx=rg_wx[l], rg_bx=rg_bx[l], rg_lam=rg_lam[l],
                  hg_out_norm=hg_out_norm[l], w_proj_rg=w_proj_rg[l], w_proj_hg=w_proj_hg[l], w_out=w_out[l])
        hl = rms_norm(xl, g_pre_mix[l]) * (1.0 + ml[1]) + ml[0]
        hc = rms_norm(xc, g_pre_mix[l]) * (1.0 + mc[1]) + mc[0]
        yc, yl = mixer(hc, hl, lp, lb_all[l], rows, need_ctx)
        xl = xl + ml[2] * rms_norm(yl, g_post_mix[l])
        hl = rms_norm(xl, g_pre_ffn[l]) * (1.0 + ml[4]) + ml[3]
        xl = xl + ml[5] * rms_norm(conv_ffn(hl, ffn_w_up[l], ffn_conv_w[l], ffn_conv_b[l], ffn_w_down[l], rows), g_post_ffn[l])
        if need_ctx:
            xc = xc + mc[2] * rms_norm(yc, g_post_mix[l])
            hc = rms_norm(xc, g_pre_ffn[l]) * (1.0 + mc[4]) + mc[3]
            xc = xc + mc[5] * rms_norm(conv_ffn(hc, ffn_w_up[l], ffn_conv_w[l], ffn_conv_b[l], ffn_w_down[l], None), g_post_ffn[l])
    return xl
```

```cpp
#include <hip/hip_runtime.h>
#include <hip/hip_cooperative_groups.h>
#include <cstdio>
namespace cg = cooperative_groups;
__device__ __forceinline__ int tid_opaque() { int t = threadIdx.x; asm volatile("" : "+v"(t)); return t; }
namespace pg8 {
#define PG8_LAS __attribute__((address_space(3)))
typedef unsigned short bf16_t;
typedef short bf16x8 __attribute__((ext_vector_type(8)));
typedef float f32x4 __attribute__((ext_vector_type(4)));
typedef unsigned u32x4 __attribute__((ext_vector_type(4)));
constexpr int BM = 256, BK = 64, HALF = 128, HTB = HALF * BK * 2  , STAGE_BYTES = 8 * HTB, NXCD = 8, WGM = 8;

__host__ __device__ __forceinline__ int lds_byte(int r, int c) { const int st = (r >> 4) * 2 + (c >> 5), rr = r & 15, cc = c & 31, ob = rr * 64 + cc * 2; return st * 1024 + (ob ^ (((ob >> 9) & 1) << 5)); }
__host__ __device__ __forceinline__ void stage_rc(int b, int& R, int& C) { const int st = b / 1024, sb = b % 1024, swz = sb ^ (((sb >> 9) & 1) << 5); R = (st >> 1) * 16 + swz / 64; C = (st & 1) * 32 + (swz % 64) / 2; }
__host__ __device__ __forceinline__ int perm32(int rho) { const int n = rho >> 4, i = rho & 15; return 8 * (i >> 2) + 4 * n + (i & 3); }

struct Unit { int pm, pn; };
struct Gemm { const bf16_t* A; const bf16_t* Bt; int M, N, K; };

struct StaticOrder {
    int nM, nN, nwg, G, c;
    __host__ __device__ void init(int M, int N, int G_, int c_) { nM = M / BM; nN = N / BM; nwg = nM * nN; G = G_; c = c_; }
    __host__ __device__ bool next(int i, Unit& u) const {
        const long L = (long)i * G + c; if (L >= nwg) return false;
        int wgid = (int)L; { const int q = nwg / NXCD, r = nwg % NXCD, xcd = wgid % NXCD, off = wgid / NXCD; wgid = (xcd < r ? xcd * (q + 1) : r * (q + 1) + (xcd - r) * q) + off; }
        const int nig = WGM * nN, gid = wgid / nig, fm = gid * WGM, gsz = (nM - fm) < WGM ? (nM - fm) : WGM;
        u.pm = fm + ((wgid % nig) % gsz); u.pn = (wgid % nig) / gsz; return true;
    }
    __device__ __forceinline__ void a_ready(const Unit&) const {}
    __device__ __forceinline__ void done(const Unit&) const {}
};
__device__ __forceinline__ unsigned cvt_pk_bf16(float lo, float hi) { unsigned r; asm volatile("v_cvt_pk_bf16_f32 %0, %1, %2" : "=v"(r) : "v"(lo), "v"(hi)); return r; }
template <class Epi, class Sched>
__device__ __forceinline__ void gemm_phase(PG8_LAS unsigned char* lds, const Gemm g, const Sched& S, const Epi& E) {
    const int tid = tid_opaque(), wid = __builtin_amdgcn_readfirstlane(tid >> 6), lane = tid & 63, wr = wid >> 2, wc = wid & 3, fr = lane & 15, fq = lane >> 4;
    const int K = g.K, nt = K / BK;
    unsigned voffA[2], voffB[2];
#pragma unroll
    for (int i = 0; i < 2; ++i) { int R, C; stage_rc(tid * 16 + i * 8192, R, C); const int Rb = Epi::PERM ? ((R & ~31) + perm32(R & 31)) : R;
        voffA[i] = (unsigned)(R * K + C) * 2u; voffB[i] = (unsigned)(Rb * K + C) * 2u; }
    const size_t kstep = (size_t)(BK * 2);
    const size_t hstep = (size_t)HALF * K * 2;
    const size_t tstep = 2 * hstep;
    const unsigned ldsw = (unsigned)wid * 1024u;
    const int aoff = lds_byte(wr * 64 + fr, fq * 8), boff = lds_byte(wc * 32 + fr, fq * 8);
#define PG8_SA(b, h) (((b) * 2 + (h)) * HTB)
#define PG8_SB(b, h) ((4 + (b) * 2 + (h)) * HTB)
#define PG8_STAGE(bufoff, gbase, voff) do { _Pragma("unroll") for (int _i = 0; _i < 2; ++_i) \
        __builtin_amdgcn_global_load_lds((const unsigned*)((const char*)(gbase) + (voff)[_i]), (PG8_LAS unsigned*)(lds + (bufoff) + ldsw + _i * 8192), 16, 0, 0); } while (0)
#define PG8_LDA(dst, b, h) do { _Pragma("unroll") for (int m = 0; m < 4; ++m) _Pragma("unroll") for (int k = 0; k < 2; ++k) dst[m][k] = *(const PG8_LAS bf16x8*)(lds + PG8_SA(b, h) + aoff + m * 2048 + k * 1024); } while (0)
#define PG8_LDB(dst, b, h) do { _Pragma("unroll") for (int n = 0; n < 2; ++n) _Pragma("unroll") for (int k = 0; k < 2; ++k) dst[n][k] = *(const PG8_LAS bf16x8*)(lds + PG8_SB(b, h) + boff + n * 2048 + k * 1024); } while (0)
#define PG8_MMA(ai, bj, At, Bt) do { __builtin_amdgcn_s_setprio(1); _Pragma("unroll") for (int m = 0; m < 4; ++m) _Pragma("unroll") for (int n = 0; n < 2; ++n) _Pragma("unroll") for (int k = 0; k < 2; ++k) \
        acc[ai][bj][m][n] = __builtin_amdgcn_mfma_f32_16x16x32_bf16(Bt[n][k], At[m][k], acc[ai][bj][m][n], 0, 0, 0); __builtin_amdgcn_s_setprio(0); } while (0)
#define PG8_WAIT_V(n) asm volatile("s_waitcnt vmcnt(" #n ")" ::: "memory")
#define PG8_WAIT_L(n) asm volatile("s_waitcnt lgkmcnt(" #n ")" ::: "memory")
#define PG8_BAR __builtin_amdgcn_s_barrier()
#define PG8_SCHED __builtin_amdgcn_sched_barrier(0)
    Unit cur, nxt; int ui = 0;
    if (!S.next(0, cur)) return;
    f32x4 acc[2][2][4][2];
#pragma unroll
    for (int a = 0; a < 2; ++a)
#pragma unroll
        for (int b = 0; b < 2; ++b)
#pragma unroll
            for (int m = 0; m < 4; ++m)
#pragma unroll
                for (int n = 0; n < 2; ++n) acc[a][b][m][n] = (f32x4){0.f, 0.f, 0.f, 0.f};
    bf16x8 At[4][2], B0[2][2], B1[2][2];
    const char* cA = (const char*)g.A + (size_t)cur.pm * tstep; const char* cB = (const char*)g.Bt + (size_t)cur.pn * tstep;
    S.a_ready(cur);
    PG8_STAGE(PG8_SB(0, 0), cB, voffB); PG8_STAGE(PG8_SA(0, 0), cA, voffA); PG8_STAGE(PG8_SB(0, 1), cB + hstep, voffB); PG8_STAGE(PG8_SA(0, 1), cA + hstep, voffA);
    if (wr == 1) PG8_BAR;
    PG8_WAIT_V(4); PG8_BAR;
    PG8_STAGE(PG8_SB(1, 0), cB + kstep, voffB); PG8_STAGE(PG8_SA(1, 0), cA + kstep, voffA); PG8_STAGE(PG8_SB(1, 1), cB + hstep + kstep, voffB);
    PG8_WAIT_V(6); PG8_BAR;
    for (;;) {
        const bool has_next = S.next(ui + 1, nxt);
        const char* nA = has_next ? (const char*)g.A + (size_t)nxt.pm * tstep : cA; const char* nB = has_next ? (const char*)g.Bt + (size_t)nxt.pn * tstep : cB;
        for (int t = 0; t < nt; t += 2) {
            const bool last = (t == nt - 2);
            const char* a1 = cA + (size_t)(t + 1) * kstep;
            const char* a2 = last ? nA : cA + (size_t)(t + 2) * kstep; const char* b2 = last ? nB : cB + (size_t)(t + 2) * kstep;
            const char* a3 = a2 + kstep; const char* b3 = b2 + kstep;
            if (last && has_next) S.a_ready(nxt);
            PG8_LDB(B0, 0, 0); PG8_SCHED; PG8_LDA(At, 0, 0); PG8_STAGE(PG8_SA(1, 1), a1 + hstep, voffA);
            PG8_WAIT_L(8); PG8_BAR; PG8_WAIT_L(0); PG8_MMA(0, 0, At, B0); PG8_BAR; PG8_SCHED;
            PG8_LDB(B1, 0, 1); PG8_STAGE(PG8_SB(0, 0), b2, voffB);
            PG8_BAR; PG8_WAIT_L(0); PG8_MMA(0, 1, At, B1); PG8_BAR;
            PG8_LDA(At, 0, 1); PG8_STAGE(PG8_SA(0, 0), a2, voffA);
            PG8_BAR; PG8_WAIT_L(0); PG8_MMA(1, 0, At, B0); PG8_BAR; PG8_SCHED;
            PG8_STAGE(PG8_SB(0, 1), b2 + hstep, voffB);
            PG8_WAIT_V(6); PG8_BAR; PG8_MMA(1, 1, At, B1); PG8_BAR;
            PG8_LDB(B0, 1, 0); PG8_SCHED; PG8_LDA(At, 1, 0); PG8_STAGE(PG8_SA(0, 1), a2 + hstep, voffA);
            PG8_WAIT_L(8); PG8_BAR; PG8_WAIT_L(0); PG8_MMA(0, 0, At, B0); PG8_BAR; PG8_SCHED;
            PG8_LDB(B1, 1, 1); PG8_STAGE(PG8_SB(1, 0), b3, voffB);
            PG8_BAR; PG8_WAIT_L(0); PG8_MMA(0, 1, At, B1); PG8_BAR;
            PG8_LDA(At, 1, 1); PG8_STAGE(PG8_SA(1, 0), a3, voffA);
            PG8_BAR; PG8_WAIT_L(0); PG8_MMA(1, 0, At, B0); PG8_BAR; PG8_SCHED;
            PG8_STAGE(PG8_SB(1, 1), b3 + hstep, voffB);
            PG8_WAIT_V(6); PG8_BAR; PG8_MMA(1, 1, At, B1); PG8_BAR;
        }
        if constexpr (!Epi::AFTER_DRAIN) { E(acc, cur, wr, wc, fr, fq); S.done(cur); }
        if (!has_next) break;
#pragma unroll
        for (int a = 0; a < 2; ++a)
#pragma unroll
            for (int b = 0; b < 2; ++b)
#pragma unroll
                for (int m = 0; m < 4; ++m)
#pragma unroll
                    for (int n = 0; n < 2; ++n) acc[a][b][m][n] = (f32x4){0.f, 0.f, 0.f, 0.f};
        cur = nxt; cA = nA; cB = nB; ++ui;
    }
    PG8_WAIT_V(0);
    if (wr == 0) PG8_BAR;
    PG8_BAR;
    if constexpr (Epi::AFTER_DRAIN) { E.fused(acc, cur, wr, wc, fr, fq, lds, wid, lane); S.done(cur); }
#undef PG8_SA
#undef PG8_SB
#undef PG8_STAGE
#undef PG8_LDA
#undef PG8_LDB
#undef PG8_MMA
#undef PG8_WAIT_V
#undef PG8_WAIT_L
#undef PG8_BAR
#undef PG8_SCHED
}
}
#define LAS __attribute__((address_space(3)))
typedef unsigned short bf16_t;
typedef short bf16x8 __attribute__((ext_vector_type(8)));
typedef float f32x4 __attribute__((ext_vector_type(4)));
typedef float f32x2 __attribute__((ext_vector_type(2)));
typedef float f32x16 __attribute__((ext_vector_type(16)));
typedef unsigned u32x4 __attribute__((ext_vector_type(4)));
typedef unsigned u32x2 __attribute__((ext_vector_type(2)));
typedef LAS unsigned char* lptr;

constexpr int D = 1024, NB = 16, SEQ = 4096, CTX = 256, DEPTH = 4;
constexpr int GB = 8, NGRP = 2;
constexpr int RC = GB * CTX;
constexpr int RL = GB * SEQ;
constexpr int MG = RC + RL;
constexpr int RCX = GB * 320;
constexpr int MGX = RCX + RL;
constexpr int INW = 9216, DFF = 2816, NUP = 2 * DFF;
constexpr int O_RGX = 0, O_RGG = 1024, O_HG = 2048, O_GA = 7168, O_GB = 8192;
constexpr float EPS = 1e-6f;
constexpr int NTHREADS = 512;
constexpr int LDS_BYTES = 147456;

constexpr size_t MiB = 1u << 20;
constexpr size_t WS_MOD = 1 * MiB;
constexpr size_t WS_XC = 3 * MiB;
constexpr size_t WS_WIN = 19 * MiB;
constexpr size_t WS_WPRG = 37 * MiB, WS_WPHG = 39 * MiB, WS_WOUT = 41 * MiB;
constexpr size_t WS_WUP = 43 * MiB;
constexpr size_t WS_WDN = 54 * MiB;
constexpr size_t WS_H = 60 * MiB;
constexpr size_t WS_R0 = 129 * MiB;
constexpr size_t WS_OF = 197 * MiB;
constexpr size_t WS_OB = 265 * MiB;
constexpr size_t WS_Z = 333 * MiB;
constexpr size_t WS_END = 945 * MiB;

__device__ __forceinline__ unsigned f2bf(float f) { unsigned u = __float_as_uint(f); return (u + 0x7fffu + ((u >> 16) & 1u)) >> 16; }
__device__ __forceinline__ unsigned pk2(float lo, float hi) { return f2bf(lo) | (f2bf(hi) << 16); }
__device__ __forceinline__ float bflo(unsigned w) { return __uint_as_float(w << 16); }
__device__ __forceinline__ float bfhi(unsigned w) { return __uint_as_float(w & 0xffff0000u); }
__device__ __forceinline__ float bf1(unsigned short s) { return __uint_as_float(((unsigned)s) << 16); }
__device__ __forceinline__ float sigm(float x) { return 1.0f / (1.0f + __expf(-x)); }
__device__ __forceinline__ float wave_sum(float v) {
#pragma unroll
    for (int o = 1; o < 64; o <<= 1) v += __shfl_xor(v, o);
    return v;
}
#define LBAR() do { asm volatile("s_waitcnt lgkmcnt(0)" ::: "memory"); __builtin_amdgcn_s_barrier(); asm volatile("" ::: "memory"); } while (0)
#define MFMA32(a, b, c) __builtin_amdgcn_mfma_f32_32x32x16_bf16((a), (b), (c), 0, 0, 0)
__device__ __forceinline__ int crow(int reg, int h) { return (reg & 3) + 8 * (reg >> 2) + 4 * h; }

struct EpiStore {
    static constexpr bool PERM = true, AFTER_DRAIN = false;
    bf16_t* O; int ldc; int row_off;
    __device__ __forceinline__ void operator()(const f32x4 (&acc)[2][2][4][2], const pg8::Unit& u, int wr, int wc, int fr, int fq) const {
        const int row0 = row_off + u.pm * 256 + wr * 64 + fr, col0 = u.pn * 256 + wc * 32 + 8 * fq;
#pragma unroll
        for (int ai = 0; ai < 2; ++ai)
#pragma unroll
            for (int m = 0; m < 4; ++m) { bf16_t* rowp = O + (size_t)(row0 + ai * 128 + m * 16) * ldc + col0;
#pragma unroll
                for (int bj = 0; bj < 2; ++bj) { const f32x4 v0 = acc[ai][bj][m][0], v1 = acc[ai][bj][m][1];
                    u32x4 w; w.x = pg8::cvt_pk_bf16(v0[0], v0[1]); w.y = pg8::cvt_pk_bf16(v0[2], v0[3]); w.z = pg8::cvt_pk_bf16(v1[0], v1[1]); w.w = pg8::cvt_pk_bf16(v1[2], v1[3]);
                    *(u32x4*)(rowp + bj * 128) = w; } }
    }
};
template <int MODE> struct EpiGate {
    static constexpr bool PERM = true, AFTER_DRAIN = false;
    const bf16_t* Zg; const bf16_t* T; bf16_t* O; int row_off;
    __device__ __forceinline__ void operator()(const f32x4 (&acc)[2][2][4][2], const pg8::Unit& u, int wr, int wc, int fr, int fq) const {
        const int row0 = row_off + u.pm * 256 + wr * 64 + fr, col0 = u.pn * 256 + wc * 32 + 8 * fq;
#pragma unroll
        for (int ai = 0; ai < 2; ++ai)
#pragma unroll
            for (int m = 0; m < 4; ++m) { const size_t row = (size_t)(row0 + ai * 128 + m * 16);
#pragma unroll
                for (int bj = 0; bj < 2; ++bj) { const int col = col0 + bj * 128;
                    const u32x4 gw = *(const u32x4*)(Zg + row * INW + col);
                    const f32x4 v0 = acc[ai][bj][m][0], v1 = acc[ai][bj][m][1];
                    float o[8];
                    o[0] = sigm(bflo(gw.x)) * v0[0]; o[1] = sigm(bfhi(gw.x)) * v0[1]; o[2] = sigm(bflo(gw.y)) * v0[2]; o[3] = sigm(bfhi(gw.y)) * v0[3];
                    o[4] = sigm(bflo(gw.z)) * v1[0]; o[5] = sigm(bfhi(gw.z)) * v1[1]; o[6] = sigm(bflo(gw.w)) * v1[2]; o[7] = sigm(bfhi(gw.w)) * v1[3];
                    if (MODE == 1) { const u32x4 tw = *(const u32x4*)(T + row * D + col);
                        o[0] += bflo(tw.x); o[1] += bfhi(tw.x); o[2] += bflo(tw.y); o[3] += bfhi(tw.y); o[4] += bflo(tw.z); o[5] += bfhi(tw.z); o[6] += bflo(tw.w); o[7] += bfhi(tw.w); }
                    u32x4 w; w.x = pg8::cvt_pk_bf16(o[0], o[1]); w.y = pg8::cvt_pk_bf16(o[2], o[3]); w.z = pg8::cvt_pk_bf16(o[4], o[5]); w.w = pg8::cvt_pk_bf16(o[6], o[7]);
                    *(u32x4*)(O + row * D + col) = w; } }
    }
};
struct EpiUp {
    static constexpr bool PERM = true, AFTER_DRAIN = false;
    bf16_t* ACT; const float* cw; const float* cb; int pm_off;
    __device__ __forceinline__ void operator()(const f32x4 (&acc)[2][2][4][2], const pg8::Unit& u, int wr, int wc, int fr, int fq) const {
        const int lane = tid_opaque() & 63;
        const int ch0 = u.pn * 128 + wc * 32 + 8 * fq;
        const int pmv = u.pm + pm_off;
        const int lup = (lane & 48) | ((lane + 1) & 15), ldn = (lane & 48) | ((lane - 1) & 15);
#pragma unroll
        for (int ai = 0; ai < 2; ++ai) {
            long drow[4]; bool ok[4];
#pragma unroll
            for (int m = 0; m < 4; ++m) {
                const int r64 = 16 * m + fr; ok[m] = true;
                if (pmv < 10) { const int G = pmv * 4 + ai * 2 + wr, bl = G / 5, gi = G - bl * 5, tok = 62 * gi - 1 + r64; ok[m] = (r64 >= 1) && (r64 <= 62) && (tok < CTX); drow[m] = (long)bl * CTX + tok; }
                else drow[m] = (long)RC + (long)(pmv - 10) * 256 + ai * 128 + wr * 64 + r64;
            }
#pragma unroll
            for (int n = 0; n < 2; ++n) {
                const int chn = ch0 + 4 * n;
                const f32x4 w0 = *(const f32x4*)(cw + chn), w1 = *(const f32x4*)(cw + DFF + chn), w2 = *(const f32x4*)(cw + 2 * DFF + chn), bb = *(const f32x4*)(cb + chn);
                float res[4][4];
#pragma unroll
                for (int j = 0; j < 4; ++j) {
                    float ru[4], rd[4];
#pragma unroll
                    for (int m = 0; m < 4; ++m) { const float gv = acc[ai][0][m][n][j]; ru[m] = __shfl(gv, lup); rd[m] = __shfl(gv, ldn); }
#pragma unroll
                    for (int m = 0; m < 4; ++m) {
                        const float up = (fr < 15) ? ru[m] : (m < 3 ? ru[m < 3 ? m + 1 : 3] : 0.f);
                        const float dn = (fr > 0) ? rd[m] : (m > 0 ? rd[m > 0 ? m - 1 : 0] : 0.f);
                        const float cv = bb[j] + w0[j] * dn + w1[j] * acc[ai][0][m][n][j] + w2[j] * up;
                        res[m][j] = cv * sigm(cv) * acc[ai][1][m][n][j];
                    }
                }
#pragma unroll
                for (int m = 0; m < 4; ++m) if (ok[m]) { u32x2 w; w.x = pg8::cvt_pk_bf16(res[m][0], res[m][1]); w.y = pg8::cvt_pk_bf16(res[m][2], res[m][3]); *(u32x2*)(ACT + (size_t)drow[m] * DFF + chn) = w; }
            }
        }
    }
};

template <bool UPMAP>
__device__ __forceinline__ void conv_item(const float* W, int K, int N, bf16_t* WT, LAS float* scr, int item, int lane) {
    const int nblk = N / 32, kb = item / nblk, nb = item % nblk, k0 = 64 * kb, n0 = 32 * nb;
#pragma unroll 8
    for (int i = 0; i < 32; ++i) { const int kk = 2 * i + (lane >> 5); scr[kk * 33 + (lane & 31)] = W[(size_t)(k0 + kk) * N + n0 + (lane & 31)]; }
    asm volatile("s_waitcnt lgkmcnt(0)" ::: "memory");
    int d0 = n0;
    if (UPMAP) { if (n0 < DFF) d0 = (n0 >> 7) * 256 + (n0 & 127); else { const int n2 = n0 - DFF; d0 = (n2 >> 7) * 256 + 128 + (n2 & 127); } }
    const int c = lane & 7;
#pragma unroll
    for (int j = 0; j < 4; ++j) { const int n = (lane >> 3) + 8 * j; const LAS float* s = scr + (8 * c) * 33 + n;
        u32x4 o; o.x = pk2(s[0 * 33], s[1 * 33]); o.y = pk2(s[2 * 33], s[3 * 33]); o.z = pk2(s[4 * 33], s[5 * 33]); o.w = pk2(s[6 * 33], s[7 * 33]);
        *(u32x4*)(WT + (size_t)(d0 + n) * K + k0 + 8 * c) = o; }
    asm volatile("s_waitcnt lgkmcnt(0)" ::: "memory");
}
struct Ptrs {
    const float *x, *c, *ctx, *c_ctx, *w_ada, *b_ada, *g_pre_mix, *g_post_mix, *g_pre_ffn, *g_post_ffn, *w_in, *rg_conv_w, *rg_conv_b, *rg_wa, *rg_ba, *rg_wx, *rg_bx, *rg_lam,
        *hg_lb, *hg_out_norm, *w_proj_rg, *w_proj_hg, *w_out, *ffn_w_up, *ffn_conv_w, *ffn_conv_b, *ffn_w_down;
    float* out; unsigned char* ws;
};
__device__ __forceinline__ void convert_weights(const Ptrs& P, lptr lds, int l) {
    const int lane = tid_opaque() & 63, wave = __builtin_amdgcn_readfirstlane(tid_opaque() >> 6);
    LAS float* scr = (LAS float*)(lds + wave * 8448);
    const int gw = blockIdx.x * 8 + wave, NGW = gridDim.x * 8;
    constexpr int I_IN = 16 * 288, I_P = 16 * 32, I_UP = 16 * 176, I_DN = 44 * 32, NIT = I_IN + 3 * I_P + I_UP + I_DN;
    for (int it = gw; it < NIT; it += NGW) {
        int r = it;
        if (r < I_IN) { conv_item<false>(P.w_in + (size_t)l * D * INW, D, INW, (bf16_t*)(P.ws + WS_WIN), scr, r, lane); continue; } r -= I_IN;
        if (r < I_P) { conv_item<false>(P.w_proj_rg + (size_t)l * D * D, D, D, (bf16_t*)(P.ws + WS_WPRG), scr, r, lane); continue; } r -= I_P;
        if (r < I_P) { conv_item<false>(P.w_proj_hg + (size_t)l * D * D, D, D, (bf16_t*)(P.ws + WS_WPHG), scr, r, lane); continue; } r -= I_P;
        if (r < I_P) { conv_item<false>(P.w_out + (size_t)l * D * D, D, D, (bf16_t*)(P.ws + WS_WOUT), scr, r, lane); continue; } r -= I_P;
        if (r < I_UP) { conv_item<true>(P.ffn_w_up + (size_t)l * D * NUP, D, NUP, (bf16_t*)(P.ws + WS_WUP), scr, r, lane); continue; } r -= I_UP;
        conv_item<false>(P.ffn_w_down + (size_t)l * DFF * D, DFF, D, (bf16_t*)(P.ws + WS_WDN), scr, r, lane);
    }
}
__device__ __forceinline__ void mods_phase(const Ptrs& P, lptr lds) {
    const int tid = tid_opaque(), lane = tid & 63, wave = __builtin_amdgcn_readfirstlane(tid >> 6);
    LAS float* S = (LAS float*)lds;
    LAS float* RED = (LAS float*)(lds + 17 * 1024 * 4);
    float* MOD = (float*)(P.ws + WS_MOD);
    for (int idx = tid; idx < 17 * 1024; idx += NTHREADS) { const int r = idx >> 10, k = idx & 1023; const float v = r < 16 ? P.c[r * 1024 + k] : P.c_ctx[k]; S[idx] = v * sigm(v); }
    __syncthreads();
    for (int task = blockIdx.x; task < 4 * 96; task += gridDim.x) {
        const int l = task / 96, n0 = (task % 96) * 64;
        float acc[17];
#pragma unroll
        for (int r = 0; r < 17; ++r) acc[r] = 0.f;
        const float* wp = P.w_ada + ((size_t)l * 1024 + wave * 128) * 6144 + n0 + lane;
#pragma unroll 4
        for (int kk = 0; kk < 128; ++kk) { const float w = wp[(size_t)kk * 6144];
#pragma unroll
            for (int r = 0; r < 17; ++r) acc[r] += S[r * 1024 + wave * 128 + kk] * w; }
#pragma unroll
        for (int r = 0; r < 17; ++r) RED[(wave * 17 + r) * 64 + lane] = acc[r];
        __syncthreads();
        for (int idx = tid; idx < 17 * 64; idx += NTHREADS) { const int r = idx >> 6, ln = idx & 63; float s = P.b_ada[l * 6144 + n0 + ln];
#pragma unroll
            for (int w = 0; w < 8; ++w) s += RED[(w * 17 + r) * 64 + ln];
            MOD[(size_t)(l * 17 + r) * 6144 + n0 + ln] = s; }
        __syncthreads();
    }
}
__device__ __forceinline__ const float* modp(const Ptrs& P, int l, int r, int j) { return (const float*)(P.ws + WS_MOD) + ((size_t)(l * 17 + r) * 6 + j) * 1024; }

__device__ __forceinline__ void row_op(const float* xsrc, float* xdst, const bf16_t* y, const float* gate, const float* gpost,
                                       const float* gpre, const float* mscale, const float* mshift, bf16_t* h0, bf16_t* h1, int lane) {
    f32x4 v[4];
#pragma unroll
    for (int j = 0; j < 4; ++j) v[j] = *((const f32x4*)xsrc + lane + 64 * j);
    if (y) {
        f32x4 yy[4]; float ss = 0.f;
#pragma unroll
        for (int j = 0; j < 4; ++j) { const u32x2 w = *((const u32x2*)y + lane + 64 * j); yy[j] = (f32x4){bflo(w.x), bfhi(w.x), bflo(w.y), bfhi(w.y)};
            ss += (yy[j][0] * yy[j][0] + yy[j][1] * yy[j][1]) + (yy[j][2] * yy[j][2] + yy[j][3] * yy[j][3]); }
        const float r = rsqrtf(wave_sum(ss) * (1.0f / 1024.0f) + EPS);
#pragma unroll
        for (int j = 0; j < 4; ++j) { const f32x4 gt = *((const f32x4*)gate + lane + 64 * j), gp = *((const f32x4*)gpost + lane + 64 * j); v[j] = v[j] + gt * (yy[j] * r * gp); }
        if (xdst) {
#pragma unroll
            for (int j = 0; j < 4; ++j) *((f32x4*)xdst + lane + 64 * j) = v[j]; }
    }
    if (h0) {
        float s2 = 0.f;
#pragma unroll
        for (int j = 0; j < 4; ++j) s2 += (v[j][0] * v[j][0] + v[j][1] * v[j][1]) + (v[j][2] * v[j][2] + v[j][3] * v[j][3]);
        const float r2 = rsqrtf(wave_sum(s2) * (1.0f / 1024.0f) + EPS);
#pragma unroll
        for (int j = 0; j < 4; ++j) { const f32x4 gp = *((const f32x4*)gpre + lane + 64 * j), sc = *((const f32x4*)mscale + lane + 64 * j), sh = *((const f32x4*)mshift + lane + 64 * j);
            const f32x4 hv = (v[j] * r2 * gp) * (sc + 1.0f) + sh;
            u32x2 w; w.x = pk2(hv[0], hv[1]); w.y = pk2(hv[2], hv[3]);
            *((u32x2*)h0 + lane + 64 * j) = w; if (h1) *((u32x2*)h1 + lane + 64 * j) = w; }
    }
}
__device__ __forceinline__ void rowop_phase(const Ptrs& P, int kind, int g, int l) {
    const int lane = tid_opaque() & 63, wave = __builtin_amdgcn_readfirstlane(tid_opaque() >> 6);
    const int gw = blockIdx.x * 8 + wave, NGW = gridDim.x * 8;
    bf16_t* H = (bf16_t*)(P.ws + WS_H); const bf16_t* Y = (const bf16_t*)(P.ws + WS_OF); float* XC = (float*)(P.ws + WS_XC);
    const int rbeg = (kind != 0 && l == 3) ? RC : 0;
    for (int r = rbeg + gw; r < MG; r += NGW) {
        const bool isc = r < RC;
        int b, mr; size_t xrow;
        if (isc) { const int bl = r >> 8, tc = r & 255; b = g * GB + bl; mr = 16; xrow = (size_t)(b * CTX + tc) * D; }
        else { const int rl = r - RC; b = g * GB + (rl >> 12); mr = b; xrow = (size_t)(b * SEQ + (rl & 4095)) * D; }
        if (kind == 0) {
            const float* xs = isc ? P.ctx + xrow : P.x + xrow;
            row_op(xs, nullptr, nullptr, nullptr, nullptr, P.g_pre_mix + l * D, modp(P, l, mr, 1), modp(P, l, mr, 0), H + (size_t)r * D, nullptr, lane);
        } else if (kind == 1) {
            const float* xs = isc ? ((l == 0 ? P.ctx : XC) + xrow) : ((l == 0 ? P.x : P.out) + xrow);
            float* xd = isc ? XC + xrow : P.out + xrow;
            bf16_t *h0, *h1 = nullptr;
            if (isc) { const int bl = r >> 8, tc = r & 255, gi = tc / 62, rr = tc - gi * 62 + 1; bf16_t* hb = H + (size_t)(bl * 320) * D;
                h0 = hb + (size_t)(gi * 64 + rr) * D;
                if (rr == 62 && gi < 4) h1 = hb + (size_t)((gi + 1) * 64) * D;
                else if (rr == 1 && gi > 0) h1 = hb + (size_t)((gi - 1) * 64 + 63) * D;
                if (tc == 0) { u32x2 zz; zz.x = 0u; zz.y = 0u;
#pragma unroll
                    for (int j = 0; j < 4; ++j) *((u32x2*)hb + lane + 64 * j) = zz; }
                if (tc == 255) { u32x2 zz; zz.x = 0u; zz.y = 0u;
                    for (int q = 9; q < 64; ++q) {
#pragma unroll
                        for (int j = 0; j < 4; ++j) *((u32x2*)(hb + (size_t)(4 * 64 + q) * D) + lane + 64 * j) = zz; } }
            } else h0 = H + (size_t)(RCX + (r - RC)) * D;
            row_op(xs, xd, Y + (size_t)r * D, modp(P, l, mr, 2), P.g_post_mix + l * D, P.g_pre_ffn + l * D, modp(P, l, mr, 4), modp(P, l, mr, 3), h0, h1, lane);
        } else {
            float* xd = isc ? XC + xrow : P.out + xrow;
            const bool nh = l < 3; const int ln = nh ? l + 1 : l;
            row_op(xd, xd, Y + (size_t)r * D, modp(P, l, mr, 5), P.g_post_ffn + l * D, P.g_pre_mix + ln * D, modp(P, ln, mr, 1), modp(P, ln, mr, 0), nh ? H + (size_t)r * D : nullptr, nullptr, lane);
        }
    }
}
__device__ __forceinline__ void hgout_phase(const Ptrs& P, int l) {
    const int lane = tid_opaque() & 63, wave = __builtin_amdgcn_readfirstlane(tid_opaque() >> 6);
    const int gw = blockIdx.x * 8 + wave, NGW = gridDim.x * 8;
    bf16_t* OF = (bf16_t*)(P.ws + WS_OF); const bf16_t* OB = (const bf16_t*)(P.ws + WS_OB); const bf16_t* Z = (const bf16_t*)(P.ws + WS_Z);
    const float* gain = P.hg_out_norm + l * D + 16 * lane;
    float gn[16];
#pragma unroll
    for (int q = 0; q < 4; ++q) { const f32x4 t = *((const f32x4*)gain + q); gn[4 * q] = t[0]; gn[4 * q + 1] = t[1]; gn[4 * q + 2] = t[2]; gn[4 * q + 3] = t[3]; }
    for (int r = (l == 3 ? RC : 0) + gw; r < MG; r += NGW) {
        const u32x4* pf = (const u32x4*)(OF + (size_t)r * D + 16 * lane); const u32x4* pb = (const u32x4*)(OB + (size_t)r * D + 16 * lane);
        const u32x4* pg = (const u32x4*)(Z + (size_t)r * INW + O_HG + 4 * 1024 + 16 * lane);
        float o[16], gv[16]; float ss = 0.f;
#pragma unroll
        for (int q = 0; q < 2; ++q) { const u32x4 a = pf[q], b = pb[q], c = pg[q];
            const unsigned aw[4] = {a.x, a.y, a.z, a.w}, bw[4] = {b.x, b.y, b.z, b.w}, cw4[4] = {c.x, c.y, c.z, c.w};
#pragma unroll
            for (int e = 0; e < 4; ++e) { const int i = 8 * q + 2 * e; o[i] = bflo(aw[e]) + bflo(bw[e]); o[i + 1] = bfhi(aw[e]) + bfhi(bw[e]); gv[i] = bflo(cw4[e]); gv[i + 1] = bfhi(cw4[e]); ss += o[i] * o[i] + o[i + 1] * o[i + 1]; } }
        ss += __shfl_xor(ss, 1); ss += __shfl_xor(ss, 2); ss += __shfl_xor(ss, 4);
        const float rr = rsqrtf(ss * (1.0f / 128.0f) + EPS);
        u32x4 w[2];
#pragma unroll
        for (int q = 0; q < 2; ++q) { unsigned pw[4];
#pragma unroll
            for (int e = 0; e < 4; ++e) { const int i = 8 * q + 2 * e; const float y0 = o[i] * rr * gn[i] * (gv[i] * sigm(gv[i])), y1 = o[i + 1] * rr * gn[i + 1] * (gv[i + 1] * sigm(gv[i + 1])); pw[e] = pk2(y0, y1); }
            w[q].x = pw[0]; w[q].y = pw[1]; w[q].z = pw[2]; w[q].w = pw[3]; }
        u32x4* po = (u32x4*)(OF + (size_t)r * D + 16 * lane); po[0] = w[0]; po[1] = w[1];
    }
}
constexpr int HQI = 0, HQD = HQI + 32 * 272, HKD = HQD + 32 * 272, HKE = HKD + 32 * 272, HVT = HKE + 128 * 80, HST = HVT + 64 * 80, HAM = HST + 64 * 272, HE = HAM + 32 * 80, HTOT = HE + 512, HEND = HTOT + 2048;
__device__ __forceinline__ int hg_row(int bl, int dir, int j, int i) {
    int s = 32 * j + i;
    if (j < 8) { const int tok = dir ? 255 - s : s; return bl * CTX + tok; }
    s -= 256; const int q = dir ? 4095 - s : s; const int tok = (q & 63) * 64 + (q >> 6); return RC + bl * SEQ + tok;
}
__device__ __forceinline__ void hg_unit(const Ptrs& P, lptr lds, int l, int u) {
    const int tid = tid_opaque(), lane = tid & 63, wave = __builtin_amdgcn_readfirstlane(tid >> 6), l31 = lane & 31, hh = lane >> 5;
    const int bl = u >> 5, head = (u >> 2) & 7, dir = (u >> 1) & 1, vh = u & 1;
    const bf16_t* Z = (const bf16_t*)(P.ws + WS_Z);
    bf16_t* O = (bf16_t*)(P.ws + (dir ? WS_OB : WS_OF));
    const int k = tid & 127, tq = tid >> 7;
    const int vc = tid & 63, tg = tid >> 6;
    float lbk;
    { const int c = head * 128 + k; const float p0 = P.hg_lb[c], p1 = P.hg_lb[1024 + c], p2 = P.hg_lb[2048 + c], p3 = P.hg_lb[3072 + c];
      const float mx = fmaxf(fmaxf(p0, p1), fmaxf(p2, p3)); const float e0 = expf(p0 - mx), e1 = expf(p1 - mx), e2 = expf(p2 - mx), e3 = expf(p3 - mx); const float inv = 1.0f / (e0 + e1 + e2 + e3);
      lbk = (l == 0) ? 0.f : (l == 1) ? e1 * inv : (l == 2) ? (e1 + e2) * inv : (e1 + e2 + e3) * inv; }
    const float oml = 1.0f - lbk;
    const bf16_t* zq = Z + O_HG + head * 128 + k;
    const bf16_t* zf = Z + O_HG + (1 + dir) * 1024 + head * 128 + k;
    const bf16_t* zv = Z + O_HG + 3 * 1024 + head * 128 + vh * 64 + vc;
    for (int i = tid; i < 64 * 272 / 4; i += NTHREADS) *(LAS unsigned*)(lds + HST + 4 * i) = 0u;
    f32x16 Sacc;
#pragma unroll
    for (int i = 0; i < 16; ++i) Sacc[i] = 0.f;
    unsigned short rq[8], rf[8], rv[4];
#define HG_LOAD(j) do { _Pragma("unroll") for (int i = 0; i < 8; ++i) { const size_t ro = (size_t)hg_row(bl, dir, (j), 8 * tq + i) * INW; rq[i] = zq[ro]; rf[i] = zf[ro]; } \
        _Pragma("unroll") for (int i = 0; i < 4; ++i) rv[i] = zv[(size_t)hg_row(bl, dir, (j), 4 * tg + i) * INW]; } while (0)
    HG_LOAD(0);
    LBAR();
    for (int j = 0; j < 136; ++j) {
        float bc[8], qv[8], kk[8]; float cum = 0.f;
#pragma unroll
        for (int i = 0; i < 8; ++i) { const float a = bf1(rq[i]); qv[i] = a * sigm(a);
            float f = bf1(rf[i]); f = fminf(fmaxf(f, -30.f), 30.f);
            const float sg = 1.0f / (1.0f + __expf(-f)); const float lf = __logf(lbk + oml * sg); kk[i] = oml / (1.0f + __expf(f)); cum += lf; bc[i] = cum; }
        unsigned short cv[4];
#pragma unroll
        for (int i = 0; i < 4; ++i) cv[i] = rv[i];
        if (j + 1 < 136) HG_LOAD(j + 1);
        *(LAS float*)(lds + HTOT + (tq * 128 + k) * 4) = cum;
        LBAR();
        const float t0 = *(LAS float*)(lds + HTOT + (0 * 128 + k) * 4), t1 = *(LAS float*)(lds + HTOT + (1 * 128 + k) * 4), t2 = *(LAS float*)(lds + HTOT + (2 * 128 + k) * 4), t3 = *(LAS float*)(lds + HTOT + (3 * 128 + k) * 4);
        const float off = (tq > 0 ? t0 : 0.f) + (tq > 1 ? t1 : 0.f) + (tq > 2 ? t2 : 0.f), ref = t0 + t1, blast = (t0 + t1) + (t2 + t3);
        unsigned ke[8];
#pragma unroll
        for (int i = 0; i < 8; ++i) { const float b = bc[i] + off; const int t = 8 * tq + i;
            *(LAS unsigned short*)(lds + HQI + t * 272 + k * 2) = (unsigned short)f2bf(qv[i] * __expf(b));
            *(LAS unsigned short*)(lds + HQD + t * 272 + k * 2) = (unsigned short)f2bf(qv[i] * __expf(b - ref));
            *(LAS unsigned short*)(lds + HKD + t * 272 + k * 2) = (unsigned short)f2bf(kk[i] * __expf(ref - b));
            ke[i] = f2bf(kk[i] * __expf(blast - b)); }
        { u32x4 w; w.x = ke[0] | (ke[1] << 16); w.y = ke[2] | (ke[3] << 16); w.z = ke[4] | (ke[5] << 16); w.w = ke[6] | (ke[7] << 16); *(LAS u32x4*)(lds + HKE + k * 80 + tq * 16) = w; }
        if (tq == 0) *(LAS float*)(lds + HE + k * 4) = __expf(blast);
        { u32x2 w; w.x = (unsigned)cv[0] | ((unsigned)cv[1] << 16); w.y = (unsigned)cv[2] | ((unsigned)cv[3] << 16); *(LAS u32x2*)(lds + HVT + vc * 80 + tg * 8) = w; }
        LBAR();
        f32x16 oacc;
#pragma unroll
        for (int i = 0; i < 16; ++i) oacc[i] = 0.f;
        if (wave == 0) {
            f32x16 aacc;
#pragma unroll
            for (int i = 0; i < 16; ++i) aacc[i] = 0.f;
#pragma unroll
            for (int ks = 0; ks < 8; ++ks) { const bf16x8 a = *(const LAS bf16x8*)(lds + HKD + l31 * 272 + 32 * ks + 16 * hh), b = *(const LAS bf16x8*)(lds + HQD + l31 * 272 + 32 * ks + 16 * hh); aacc = MFMA32(a, b, aacc); }
#pragma unroll
            for (int gq = 0; gq < 4; ++gq) { const int s0 = 8 * gq + 4 * hh; float m[4];
#pragma unroll
                for (int e = 0; e < 4; ++e) m[e] = (s0 + e <= l31) ? aacc[4 * gq + e] : 0.f;
                u32x2 w; w.x = pk2(m[0], m[1]); w.y = pk2(m[2], m[3]); *(LAS u32x2*)(lds + HAM + l31 * 80 + s0 * 2) = w; }
        } else if (wave <= 2) {
            const int vi = wave - 1;
#pragma unroll
            for (int ks = 0; ks < 8; ++ks) { const bf16x8 a = *(const LAS bf16x8*)(lds + HQI + l31 * 272 + 32 * ks + 16 * hh), b = *(const LAS bf16x8*)(lds + HST + (32 * vi + l31) * 272 + 32 * ks + 16 * hh); oacc = MFMA32(a, b, oacc); }
        }
        LBAR();
        if (wave == 1 || wave == 2) {
            const int vi = wave - 1;
#pragma unroll
            for (int ks = 0; ks < 2; ++ks) { const bf16x8 a = *(const LAS bf16x8*)(lds + HAM + l31 * 80 + 32 * ks + 16 * hh), b = *(const LAS bf16x8*)(lds + HVT + (32 * vi + l31) * 80 + 32 * ks + 16 * hh); oacc = MFMA32(a, b, oacc); }
#pragma unroll
            for (int r = 0; r < 16; ++r) { const int t = crow(r, hh); O[(size_t)hg_row(bl, dir, j, t) * D + head * 128 + vh * 64 + 32 * vi + l31] = (bf16_t)f2bf(oacc[r]); }
        }
        { const int ki = wave & 3, vi2 = wave >> 2;
#pragma unroll
          for (int gq = 0; gq < 4; ++gq) { const f32x4 e4 = *(const LAS f32x4*)(lds + HE + (32 * ki + 8 * gq + 4 * hh) * 4);
#pragma unroll
              for (int e = 0; e < 4; ++e) Sacc[4 * gq + e] *= e4[e]; }
#pragma unroll
          for (int ks = 0; ks < 2; ++ks) { const bf16x8 a = *(const LAS bf16x8*)(lds + HKE + (32 * ki + l31) * 80 + 32 * ks + 16 * hh), b = *(const LAS bf16x8*)(lds + HVT + (32 * vi2 + l31) * 80 + 32 * ks + 16 * hh); Sacc = MFMA32(a, b, Sacc); }
#pragma unroll
          for (int gq = 0; gq < 4; ++gq) { u32x2 w; w.x = pk2(Sacc[4 * gq], Sacc[4 * gq + 1]); w.y = pk2(Sacc[4 * gq + 2], Sacc[4 * gq + 3]);
              *(LAS u32x2*)(lds + HST + (32 * vi2 + l31) * 272 + (32 * ki + 8 * gq + 4 * hh) * 2) = w; } }
        LBAR();
    }
#undef HG_LOAD
}

constexpr int RXB = 0, RXF = RXB + 128 * 144, RAA = RXF + 128 * 128, RSQ = RAA + 128 * 128, RIG = RSQ + 128 * 128, RCAR = RIG + 128 * 128, RCARRY = RCAR + 16 * 32 * 8, REND = RCARRY + 256;
__device__ __forceinline__ float gelu_tanh(float x) { const float u = 0.7978845608028654f * (x + 0.044715f * x * x * x); return 0.5f * x * (1.0f + tanhf(u)); }
__device__ __forceinline__ void rg_unit(const Ptrs& P, lptr lds, int l, int u) {
    const int tid = tid_opaque(), lane = tid & 63, wave = __builtin_amdgcn_readfirstlane(tid >> 6), l31 = lane & 31, hh = lane >> 5;
    const int bl = u >> 5, head = (u >> 1) & 15, hf = u & 1;
    const int c0 = head * 64;
    const bf16_t* Z = (const bf16_t*)(P.ws + WS_Z);
    bf16_t* R0 = (bf16_t*)(P.ws + WS_R0);
    const int cp = tid & 31, tg = tid >> 5;
    float cwv[2][4], cbv[2];
#pragma unroll
    for (int e = 0; e < 2; ++e) { cbv[e] = P.rg_conv_b[l * 1024 + c0 + 2 * cp + e];
#pragma unroll
        for (int jj = 0; jj < 4; ++jj) cwv[e][jj] = P.rg_conv_w[(l * 4 + jj) * 1024 + c0 + 2 * cp + e]; }
    const int sc = tid & 31, sub = tid >> 5;
    const int mych = c0 + 32 * hf + sc;
    const int mt = wave & 3, gate = wave >> 2;
    for (int d = 0; d < 2; ++d) {
        const float* Wg = (gate == 0 ? P.rg_wa : P.rg_wx) + ((size_t)((l * 2 + d) * 16 + head) * 64) * 64 + 32 * hf + l31;
        bf16x8 wf[4];
#pragma unroll
        for (int ks = 0; ks < 4; ++ks) { unsigned pw[4];
#pragma unroll
            for (int e = 0; e < 4; ++e) { const int i0 = 16 * ks + 8 * hh + 2 * e; pw[e] = pk2(Wg[(size_t)i0 * 64], Wg[(size_t)(i0 + 1) * 64]); }
            u32x4 t; t.x = pw[0]; t.y = pw[1]; t.z = pw[2]; t.w = pw[3]; wf[ks] = __builtin_bit_cast(bf16x8, t); }
        const int gch = (l * 2 + d) * 1024 + c0 + 32 * hf + l31;
        const float lam = P.rg_lam[gch];
        const float c8 = 8.0f * log1pf(expf(-lam));
        const float gbias = (gate == 0 ? P.rg_ba : P.rg_bx)[gch];
        LBAR();
        if (tid < 32) *(LAS float*)(lds + RCARRY + tid * 4) = 0.f;
        for (int n = 0; n < 34; ++n) {
            int jt, len; size_t rbase;
            if (n < 2) { jt = d ? 1 - n : n; len = CTX; rbase = (size_t)bl * CTX; }
            else { jt = d ? 33 - n : n - 2; len = SEQ; rbase = (size_t)RC + (size_t)bl * SEQ; }
            const int t0 = 128 * jt;
            float z0[11], z1[11];
#pragma unroll
            for (int i = 0; i < 11; ++i) { const int t = t0 + 8 * tg + i - 1; unsigned w = 0u; if (t >= 0 && t < len) w = *(const unsigned*)(Z + (rbase + t) * INW + O_RGX + c0 + 2 * cp); z0[i] = bflo(w); z1[i] = bfhi(w); }
            unsigned short gr[8], hr[8];
            if (d == 1) {
#pragma unroll
                for (int ii = 0; ii < 8; ++ii) { const size_t row = rbase + t0 + 8 * sub + (7 - ii); gr[ii] = Z[row * INW + O_RGG + mych]; hr[ii] = R0[row * D + mych]; }
            }
#pragma unroll
            for (int i = 0; i < 8; ++i) {
                const float x0 = cbv[0] + cwv[0][0] * z0[i] + cwv[0][1] * z0[i + 1] + cwv[0][2] * z0[i + 2] + cwv[0][3] * z0[i + 3];
                const float x1 = cbv[1] + cwv[1][0] * z1[i] + cwv[1][1] * z1[i + 1] + cwv[1][2] * z1[i + 2] + cwv[1][3] * z1[i + 3];
                const int tt = 8 * tg + i;
                *(LAS unsigned*)(lds + RXB + tt * 144 + cp * 4) = pk2(x0, x1);
                if ((cp >> 4) == hf) { f32x2 xx; xx.x = x0; xx.y = x1; *(LAS f32x2*)(lds + RXF + tt * 128 + (cp & 15) * 8) = xx; }
            }
            LBAR();
            { f32x16 acc;
#pragma unroll
              for (int i = 0; i < 16; ++i) acc[i] = 0.f;
#pragma unroll
              for (int ks = 0; ks < 4; ++ks) { const bf16x8 a = *(const LAS bf16x8*)(lds + RXB + (32 * mt + l31) * 144 + 32 * ks + 16 * hh); acc = MFMA32(a, wf[ks], acc); }
#pragma unroll
              for (int r = 0; r < 16; ++r) { const int tt = 32 * mt + crow(r, hh); const float sg = sigm(acc[r] + gbias);
                  if (gate == 0) { const float la = -c8 * sg; *(LAS float*)(lds + RAA + tt * 128 + l31 * 4) = __expf(la); *(LAS float*)(lds + RSQ + tt * 128 + l31 * 4) = sqrtf(fmaxf(-expm1f(2.0f * la), 0.f)); }
                  else *(LAS float*)(lds + RIG + tt * 128 + l31 * 4) = sg; } }
            LBAR();
            float av[8], bv[8]; float Pp = 1.f, Hl = 0.f;
#pragma unroll
            for (int ii = 0; ii < 8; ++ii) { const int i = d ? 7 - ii : ii; const int tt = 8 * sub + i;
                const float a = *(LAS float*)(lds + RAA + tt * 128 + sc * 4);
                const float b = *(LAS float*)(lds + RSQ + tt * 128 + sc * 4) * *(LAS float*)(lds + RIG + tt * 128 + sc * 4) * *(LAS float*)(lds + RXF + tt * 128 + sc * 4);
                av[ii] = a; bv[ii] = b; Hl = a * Hl + b; Pp *= a; }
            { f32x2 ph; ph.x = Pp; ph.y = Hl; *(LAS f32x2*)(lds + RCAR + (sub * 32 + sc) * 8) = ph; }
            LBAR();
            float hin = *(LAS float*)(lds + RCARRY + ((n & 1) * 32 + sc) * 4);
            if (d == 0) { for (int s2 = 0; s2 < sub; ++s2) { const f32x2 ph = *(LAS f32x2*)(lds + RCAR + (s2 * 32 + sc) * 8); hin = ph.x * hin + ph.y; } }
            else { for (int s2 = 15; s2 > sub; --s2) { const f32x2 ph = *(LAS f32x2*)(lds + RCAR + (s2 * 32 + sc) * 8); hin = ph.x * hin + ph.y; } }
#pragma unroll
            for (int ii = 0; ii < 8; ++ii) { const int i = d ? 7 - ii : ii; const size_t row = rbase + t0 + 8 * sub + i;
                hin = av[ii] * hin + bv[ii];
                if (d == 0) R0[row * D + mych] = (bf16_t)f2bf(hin);
                else { const float gg = bf1(gr[ii]); R0[row * D + mych] = (bf16_t)f2bf(gelu_tanh(gg) * (bf1(hr[ii]) + hin)); } }
            if ((d == 0 && sub == 15) || (d == 1 && sub == 0)) *(LAS float*)(lds + RCARRY + (((n + 1) & 1) * 32 + sc) * 4) = hin;
        }
    }
    LBAR();
}
struct Args { Ptrs p; int lo, hi; };
__global__ void __launch_bounds__(NTHREADS, 2) mega_fwd(Args args) {
    extern __shared__ __attribute__((aligned(16))) unsigned char lds_raw[];
    cg::grid_group grid = cg::this_grid();
    lptr lds = (lptr)lds_raw;
    const int lo = args.lo, hi = args.hi;
    typedef const Args __attribute__((address_space(4)))* kargp_t;
#define KP() ({ kargp_t _p = (kargp_t)__builtin_amdgcn_kernarg_segment_ptr(); asm volatile("" : "+s"(_p)); _p; })
#define GETP() Ptrs P; { kargp_t _kp = KP(); const unsigned long long* _src = (const unsigned long long*)_kp; unsigned long long* _dst = (unsigned long long*)&P; _Pragma("unroll") for (int _i = 0; _i < 29; ++_i) _dst[_i] = _src[_i]; } unsigned char* ws = P.ws;
    int ph = 0;
#define RUN (ph >= lo && ph < hi)
#define SEAM() do { ++ph; if (ph > lo && ph < hi) grid.sync(); } while (0)
#define BUFS() bf16_t* H = (bf16_t*)(ws + WS_H); bf16_t* R0 = (bf16_t*)(ws + WS_R0); bf16_t* OF = (bf16_t*)(ws + WS_OF); bf16_t* OB = (bf16_t*)(ws + WS_OB); bf16_t* Z = (bf16_t*)(ws + WS_Z); bf16_t* ACT = Z; (void)H; (void)R0; (void)OF; (void)OB; (void)ACT;
    const int G = gridDim.x, bid = blockIdx.x;

    if (RUN) { GETP(); BUFS(); mods_phase(P, lds); __syncthreads(); convert_weights(P, lds, 0); }
    SEAM();
    if (RUN) { GETP(); BUFS(); rowop_phase(P, 0, 0, 0); }
    SEAM();
    for (int g = 0; g < NGRP; ++g) {
        for (int l = 0; l < DEPTH; ++l) {
            const bool last = (l == DEPTH - 1);
            const int roff = last ? RC : 0, Mm = last ? RL : MG;
            if (RUN) { GETP(); BUFS(); pg8::Gemm gm{H, (const bf16_t*)(ws + WS_WIN), MG, INW, D}; pg8::StaticOrder S; S.init(MG, INW, G, bid); EpiStore E{Z, INW, 0}; pg8::gemm_phase<EpiStore, pg8::StaticOrder>(lds, gm, S, E); }
            SEAM();
            if (RUN) { GETP(); BUFS(); for (int u = bid; u < 256; u += G) hg_unit(P, lds, l, u);
                       for (int u = bid; u < 256; u += G) rg_unit(P, lds, l, u); }
            SEAM();
            if (RUN) { GETP(); BUFS(); hgout_phase(P, l); }
            SEAM();
            if (RUN) { GETP(); BUFS(); pg8::StaticOrder S; S.init(Mm, D, G, bid);
                { pg8::Gemm gm{R0 + (size_t)roff * D, (const bf16_t*)(ws + WS_WPRG), Mm, D, D}; EpiGate<0> E{Z + O_GA, nullptr, H, roff}; pg8::gemm_phase<EpiGate<0>, pg8::StaticOrder>(lds, gm, S, E); }
                { pg8::Gemm gm{OF + (size_t)roff * D, (const bf16_t*)(ws + WS_WPHG), Mm, D, D}; EpiGate<1> E{Z + O_GB, H, OB, roff}; pg8::gemm_phase<EpiGate<1>, pg8::StaticOrder>(lds, gm, S, E); } }
            SEAM();
            if (RUN) { GETP(); BUFS(); pg8::Gemm gm{OB + (size_t)roff * D, (const bf16_t*)(ws + WS_WOUT), Mm, D, D}; pg8::StaticOrder S; S.init(Mm, D, G, bid); EpiStore E{OF, D, roff}; pg8::gemm_phase<EpiStore, pg8::StaticOrder>(lds, gm, S, E); }
            SEAM();
            if (RUN) { GETP(); BUFS(); rowop_phase(P, 1, g, l); }
            SEAM();
            if (RUN) { GETP(); BUFS(); const int xoff = last ? RCX : 0, Mu = last ? RL : MGX;
                pg8::Gemm gm{H + (size_t)xoff * D, (const bf16_t*)(ws + WS_WUP), Mu, NUP, D}; pg8::StaticOrder S; S.init(Mu, NUP, G, bid);
                EpiUp E{ACT, P.ffn_conv_w + (size_t)l * 3 * DFF, P.ffn_conv_b + (size_t)l * DFF, last ? 10 : 0}; pg8::gemm_phase<EpiUp, pg8::StaticOrder>(lds, gm, S, E); }
            SEAM();
            if (RUN) { GETP(); BUFS(); pg8::Gemm gm{ACT + (size_t)roff * DFF, (const bf16_t*)(ws + WS_WDN), Mm, D, DFF}; pg8::StaticOrder S; S.init(Mm, D, G, bid); EpiStore E{OF, D, roff}; pg8::gemm_phase<EpiStore, pg8::StaticOrder>(lds, gm, S, E); }
            SEAM();
            if (RUN) { GETP(); BUFS(); rowop_phase(P, 2, g, l);
                if (!last) convert_weights(P, lds, l + 1);
                else if (g + 1 < NGRP) { convert_weights(P, lds, 0); rowop_phase(P, 0, g + 1, 0); } }
            SEAM();
        }
    }
#undef RUN
#undef SEAM
}
constexpr int N_PHASES = 2 + NGRP * DEPTH * 9;

extern "C" void kernel_launch(void* const* d_in, const int* in_sizes, int n_in, void* d_out, int out_size, void* d_ws, size_t ws_size, hipStream_t stream) {
    static int grid = 0;
    if (grid == 0) {
        if (n_in != 27 || ws_size < WS_END) { fprintf(stderr, "kernel_launch: unexpected n_in %d or ws_size %zu (< %zu)\n", n_in, ws_size, (size_t)WS_END); grid = -1; return; }
        int dev = 0, cus = 0, per_cu = 0;
        (void)hipGetDevice(&dev);
        (void)hipDeviceGetAttribute(&cus, hipDeviceAttributeMultiprocessorCount, dev);
        if (hipFuncSetAttribute((const void*)mega_fwd, hipFuncAttributeMaxDynamicSharedMemorySize, LDS_BYTES) != hipSuccess) { fprintf(stderr, "kernel_launch: hipFuncSetAttribute failed\n"); grid = -1; return; }
        if (hipOccupancyMaxActiveBlocksPerMultiprocessor(&per_cu, (const void*)mega_fwd, NTHREADS, LDS_BYTES) != hipSuccess || per_cu < 1) { fprintf(stderr, "kernel_launch: occupancy query says %d\n", per_cu); per_cu = 1; }
        (void)hipGetLastError();
        grid = cus * 1;
        fprintf(stderr, "kernel_launch: cus %d per_cu %d grid %d\n", cus, per_cu, grid);
    }
    if (grid < 0) return;
    Args a{};
    const float** pp = (const float**)&a.p;
    for (int i = 0; i < 27; ++i) pp[i] = (const float*)d_in[i];
    a.p.out = (float*)d_out; a.p.ws = (unsigned char*)d_ws;
#ifdef MULTI_LAUNCH
    for (int p = 0; p < N_PHASES; ++p) { a.lo = p; a.hi = p + 1; hipLaunchKernelGGL(mega_fwd, dim3(grid), dim3(NTHREADS), LDS_BYTES, stream, a); }
#else
    a.lo = 0; a.hi = N_PHASES;
    void* kargs[] = {&a};
    hipError_t e = hipLaunchCooperativeKernel((void*)mega_fwd, dim3(grid), dim3(NTHREADS), kargs, LDS_BYTES, stream);
    if (e != hipSuccess) fprintf(stderr, "cooperative launch failed: %s (grid %d)\n", hipGetErrorString(e), grid);
#endif
}
```

```cpp
#include <hip/hip_runtime.h>
#include <hip/hip_cooperative_groups.h>
#include <cstdio>
namespace cg = cooperative_groups;
__device__ __forceinline__ int tid_opaque() { int t = threadIdx.x; asm volatile("" : "+v"(t)); return t; }
namespace pg8 {
#define PG8_LAS __attribute__((address_space(3)))
typedef unsigned short bf16_t;
typedef short bf16x8 __attribute__((ext_vector_type(8)));
typedef float f32x4 __attribute__((ext_vector_type(4)));
typedef unsigned u32x4 __attribute__((ext_vector_type(4)));
constexpr int BM = 256, BK = 64, HALF = 128, HTB = HALF * BK * 2  , STAGE_BYTES = 8 * HTB, NXCD = 8, WGM = 8;

__host__ __device__ __forceinline__ int lds_byte(int r, int c) { const int st = (r >> 4) * 2 + (c >> 5), rr = r & 15, cc = c & 31, ob = rr * 64 + cc * 2; return st * 1024 + (ob ^ (((ob >> 9) & 1) << 5)); }
__host__ __device__ __forceinline__ void stage_rc(int b, int& R, int& C) { const int st = b / 1024, sb = b % 1024, swz = sb ^ (((sb >> 9) & 1) << 5); R = (st >> 1) * 16 + swz / 64; C = (st & 1) * 32 + (swz % 64) / 2; }
__host__ __device__ __forceinline__ int perm32(int rho) { const int n = rho >> 4, i = rho & 15; return 8 * (i >> 2) + 4 * n + (i & 3); }

struct Unit { int pm, pn; };
struct Gemm { const bf16_t* A; const bf16_t* Bt; int M, N, K; };

struct StaticOrder {
    int nM, nN, nwg, G, c;
    __host__ __device__ void init(int M, int N, int G_, int c_) { nM = M / BM; nN = N / BM; nwg = nM * nN; G = G_; c = c_; }
    __host__ __device__ bool next(int i, Unit& u) const {
        const long L = (long)i * G + c; if (L >= nwg) return false;
        int wgid = (int)L; { const int q = nwg / NXCD, r = nwg % NXCD, xcd = wgid % NXCD, off = wgid / NXCD; wgid = (xcd < r ? xcd * (q + 1) : r * (q + 1) + (xcd - r) * q) + off; }
        const int nig = WGM * nN, gid = wgid / nig, fm = gid * WGM, gsz = (nM - fm) < WGM ? (nM - fm) : WGM;
        u.pm = fm + ((wgid % nig) % gsz); u.pn = (wgid % nig) / gsz; return true;
    }
    __device__ __forceinline__ void a_ready(const Unit&) const {}
    __device__ __forceinline__ void done(const Unit&) const {}
};
__device__ __forceinline__ unsigned cvt_pk_bf16(float lo, float hi) { unsigned r; asm volatile("v_cvt_pk_bf16_f32 %0, %1, %2" : "=v"(r) : "v"(lo), "v"(hi)); return r; }
template <class Epi, class Sched>
__device__ __forceinline__ void gemm_phase(PG8_LAS unsigned char* lds, const Gemm g, const Sched& S, const Epi& E) {
    const int tid = tid_opaque(), wid = __builtin_amdgcn_readfirstlane(tid >> 6), lane = tid & 63, wr = wid >> 2, wc = wid & 3, fr = lane & 15, fq = lane >> 4;
    const int K = g.K, nt = K / BK;
    unsigned voffA[2], voffB[2];
#pragma unroll
    for (int i = 0; i < 2; ++i) { int R, C; stage_rc(tid * 16 + i * 8192, R, C); const int Rb = Epi::PERM ? ((R & ~31) + perm32(R & 31)) : R;
        voffA[i] = (unsigned)(R * K + C) * 2u; voffB[i] = (unsigned)(Rb * K + C) * 2u; }
    const size_t kstep = (size_t)(BK * 2);
    const size_t hstep = (size_t)HALF * K * 2;
    const size_t tstep = 2 * hstep;
    const unsigned ldsw = (unsigned)wid * 1024u;
    const int aoff = lds_byte(wr * 64 + fr, fq * 8), boff = lds_byte(wc * 32 + fr, fq * 8);
#define PG8_SA(b, h) (((b) * 2 + (h)) * HTB)
#define PG8_SB(b, h) ((4 + (b) * 2 + (h)) * HTB)
#define PG8_STAGE(bufoff, gbase, voff) do { _Pragma("unroll") for (int _i = 0; _i < 2; ++_i) \
        __builtin_amdgcn_global_load_lds((const unsigned*)((const char*)(gbase) + (voff)[_i]), (PG8_LAS unsigned*)(lds + (bufoff) + ldsw + _i * 8192), 16, 0, 0); } while (0)
#define PG8_LDA(dst, b, h) do { _Pragma("unroll") for (int m = 0; m < 4; ++m) _Pragma("unroll") for (int k = 0; k < 2; ++k) dst[m][k] = *(const PG8_LAS bf16x8*)(lds + PG8_SA(b, h) + aoff + m * 2048 + k * 1024); } while (0)
#define PG8_LDB(dst, b, h) do { _Pragma("unroll") for (int n = 0; n < 2; ++n) _Pragma("unroll") for (int k = 0; k < 2; ++k) dst[n][k] = *(const PG8_LAS bf16x8*)(lds + PG8_SB(b, h) + boff + n * 2048 + k * 1024); } while (0)
#define PG8_MMA(ai, bj, At, Bt) do { __builtin_amdgcn_s_setprio(1); _Pragma("unroll") for (int m = 0; m < 4; ++m) _Pragma("unroll") for (int n = 0; n < 2; ++n) _Pragma("unroll") for (int k = 0; k < 2; ++k) \
        acc[ai][bj][m][n] = __builtin_amdgcn_mfma_f32_16x16x32_bf16(Bt[n][k], At[m][k], acc[ai][bj][m][n], 0, 0, 0); __builtin_amdgcn_s_setprio(0); } while (0)
#define PG8_WAIT_V(n) asm volatile("s_waitcnt vmcnt(" #n ")" ::: "memory")
#define PG8_WAIT_L(n) asm volatile("s_waitcnt lgkmcnt(" #n ")" ::: "memory")
#define PG8_BAR __builtin_amdgcn_s_barrier()
#define PG8_SCHED __builtin_amdgcn_sched_barrier(0)
    Unit cur, nxt; int ui = 0;
    if (!S.next(0, cur)) return;
    f32x4 acc[2][2][4][2];
#pragma unroll
    for (int a = 0; a < 2; ++a)
#pragma unroll
        for (int b = 0; b < 2; ++b)
#pragma unroll
            for (int m = 0; m < 4; ++m)
#pragma unroll
                for (int n = 0; n < 2; ++n) acc[a][b][m][n] = (f32x4){0.f, 0.f, 0.f, 0.f};
    bf16x8 At[4][2], B0[2][2], B1[2][2];
    const char* cA = (const char*)g.A + (size_t)cur.pm * tstep; const char* cB = (const char*)g.Bt + (size_t)cur.pn * tstep;
    S.a_ready(cur);
    PG8_STAGE(PG8_SB(0, 0), cB, voffB); PG8_STAGE(PG8_SA(0, 0), cA, voffA); PG8_STAGE(PG8_SB(0, 1), cB + hstep, voffB); PG8_STAGE(PG8_SA(0, 1), cA + hstep, voffA);
    if (wr == 1) PG8_BAR;
    PG8_WAIT_V(4); PG8_BAR;
    PG8_STAGE(PG8_SB(1, 0), cB + kstep, voffB); PG8_STAGE(PG8_SA(1, 0), cA + kstep, voffA); PG8_STAGE(PG8_SB(1, 1), cB + hstep + kstep, voffB);
    PG8_WAIT_V(6); PG8_BAR;
    for (;;) {
        const bool has_next = S.next(ui + 1, nxt);
        const char* nA = has_next ? (const char*)g.A + (size_t)nxt.pm * tstep : cA; const char* nB = has_next ? (const char*)g.Bt + (size_t)nxt.pn * tstep : cB;
        for (int t = 0; t < nt; t += 2) {
            const bool last = (t == nt - 2);
            const char* a1 = cA + (size_t)(t + 1) * kstep;
            const char* a2 = last ? nA : cA + (size_t)(t + 2) * kstep; const char* b2 = last ? nB : cB + (size_t)(t + 2) * kstep;
            const char* a3 = a2 + kstep; const char* b3 = b2 + kstep;
            if (last && has_next) S.a_ready(nxt);
            PG8_LDB(B0, 0, 0); PG8_SCHED; PG8_LDA(At, 0, 0); PG8_STAGE(PG8_SA(1, 1), a1 + hstep, voffA);
            PG8_WAIT_L(8); PG8_BAR; PG8_WAIT_L(0); PG8_MMA(0, 0, At, B0); PG8_BAR; PG8_SCHED;
            PG8_LDB(B1, 0, 1); PG8_STAGE(PG8_SB(0, 0), b2, voffB);
            PG8_BAR; PG8_WAIT_L(0); PG8_MMA(0, 1, At, B1); PG8_BAR;
            PG8_LDA(At, 0, 1); PG8_STAGE(PG8_SA(0, 0), a2, voffA);
            PG8_BAR; PG8_WAIT_L(0); PG8_MMA(1, 0, At, B0); PG8_BAR; PG8_SCHED;
            PG8_STAGE(PG8_SB(0, 1), b2 + hstep, voffB);
            PG8_WAIT_V(6); PG8_BAR; PG8_MMA(1, 1, At, B1); PG8_BAR;
            PG8_LDB(B0, 1, 0); PG8_SCHED; PG8_LDA(At, 1, 0); PG8_STAGE(PG8_SA(0, 1), a2 + hstep, voffA);
            PG8_WAIT_L(8); PG8_BAR; PG8_WAIT_L(0); PG8_MMA(0, 0, At, B0); PG8_BAR; PG8_SCHED;
            PG8_LDB(B1, 1, 1); PG8_STAGE(PG8_SB(1, 0), b3, voffB);
            PG8_BAR; PG8_WAIT_L(0); PG8_MMA(0, 1, At, B1); PG8_BAR;
            PG8_LDA(At, 1, 1); PG8_STAGE(PG8_SA(1, 0), a3, voffA);
            PG8_BAR; PG8_WAIT_L(0); PG8_MMA(1, 0, At, B0); PG8_BAR; PG8_SCHED;
            PG8_STAGE(PG8_SB(1, 1), b3 + hstep, voffB);
            PG8_WAIT_V(6); PG8_BAR; PG8_MMA(1, 1, At, B1); PG8_BAR;
        }
        if constexpr (!Epi::AFTER_DRAIN) { E(acc, cur, wr, wc, fr, fq); S.done(cur); }
        if (!has_next) break;
#pragma unroll
        for (int a = 0; a < 2; ++a)
#pragma unroll
            for (int b = 0; b < 2; ++b)
#pragma unroll
                for (int m = 0; m < 4; ++m)
#pragma unroll
                    for (int n = 0; n < 2; ++n) acc[a][b][m][n] = (f32x4){0.f, 0.f, 0.f, 0.f};
        cur = nxt; cA = nA; cB = nB; ++ui;
    }
    PG8_WAIT_V(0);
    if (wr == 0) PG8_BAR;
    PG8_BAR;
    if constexpr (Epi::AFTER_DRAIN) { E.fused(acc, cur, wr, wc, fr, fq, lds, wid, lane); S.done(cur); }
#undef PG8_SA
#undef PG8_SB
#undef PG8_STAGE
#undef PG8_LDA
#undef PG8_LDB
#undef PG8_MMA
#undef PG8_WAIT_V
#undef PG8_WAIT_L
#undef PG8_BAR
#undef PG8_SCHED
}
}
#define LAS __attribute__((address_space(3)))
#define GAS __attribute__((address_space(1)))
typedef unsigned short bf16_t;
typedef short bf16x8 __attribute__((ext_vector_type(8)));
typedef float f32x4 __attribute__((ext_vector_type(4)));
typedef float f32x2 __attribute__((ext_vector_type(2)));
typedef float f32x16 __attribute__((ext_vector_type(16)));
typedef unsigned u32x4 __attribute__((ext_vector_type(4)));
typedef unsigned u32x2 __attribute__((ext_vector_type(2)));
typedef LAS unsigned char* lptr;

constexpr int D = 1024, NB = 16, SEQ = 4096, CTX = 256, DEPTH = 4;
constexpr int GB = 8, NGRP = 2;
constexpr int RC = GB * CTX;
constexpr int RL = GB * SEQ;
constexpr int MG = RC + RL;
constexpr int RCX = GB * 320;
constexpr int MGX = RCX + RL;
constexpr int INW = 9216, DFF = 2816, NUP = 2 * DFF;
constexpr int O_RGX = 0, O_RGG = 1024, O_HG = 2048, O_GA = 7168, O_GB = 8192;
constexpr float EPS = 1e-6f;
constexpr int NTHREADS = 512;
constexpr int LDS_BYTES = 155648;
constexpr int XB_LDS_OFF = LDS_BYTES - 64;

constexpr size_t MiB = 1u << 20;
constexpr size_t WS_MOD = 1 * MiB;
constexpr size_t WS_LB = 2 * MiB + 768 * 1024;
constexpr size_t WS_XC = 3 * MiB;
constexpr size_t WS_WIN = 19 * MiB;
constexpr size_t WS_WPRG = 37 * MiB, WS_WPHG = 39 * MiB, WS_WOUT = 41 * MiB;
constexpr size_t WS_WUP = 43 * MiB;
constexpr size_t WS_WDN = 54 * MiB;
constexpr size_t WS_H = 60 * MiB;
constexpr size_t WS_R0 = 129 * MiB;
constexpr size_t WS_OF = 197 * MiB;
constexpr size_t WS_OB = 265 * MiB;
constexpr size_t WS_Z = 333 * MiB;
constexpr size_t WS_END = 945 * MiB;

__device__ __forceinline__ unsigned f2bf(float f) { unsigned u = __float_as_uint(f); return (u + 0x7fffu + ((u >> 16) & 1u)) >> 16; }
__device__ __forceinline__ unsigned pk2(float lo, float hi) { unsigned r; asm("v_cvt_pk_bf16_f32 %0, %1, %2" : "=v"(r) : "v"(lo), "v"(hi)); return r; }
__device__ __forceinline__ float bflo(unsigned w) { return __uint_as_float(w << 16); }
__device__ __forceinline__ float bfhi(unsigned w) { return __uint_as_float(w & 0xffff0000u); }
__device__ __forceinline__ float bf1(unsigned short s) { return __uint_as_float(((unsigned)s) << 16); }
__device__ __forceinline__ float sigm(float x) { return __builtin_amdgcn_rcpf(1.0f + __builtin_amdgcn_exp2f(-1.4426950408889634f * x)); }
__device__ __forceinline__ float wave_sum(float v) {
#pragma unroll
    for (int o = 1; o < 64; o <<= 1) v += __shfl_xor(v, o);
    return v;
}
#define LBAR() do { asm volatile("s_waitcnt lgkmcnt(0)" ::: "memory"); __builtin_amdgcn_s_barrier(); asm volatile("" ::: "memory"); } while (0)
#define MFMA32(a, b, c) __builtin_amdgcn_mfma_f32_32x32x16_bf16((a), (b), (c), 0, 0, 0)
__device__ __forceinline__ int crow(int reg, int h) { return (reg & 3) + 8 * (reg >> 2) + 4 * h; }

struct EpiStore {
    static constexpr bool PERM = true, AFTER_DRAIN = false;
    GAS bf16_t* O; int ldc; int row_off;
    __device__ __forceinline__ void operator()(const f32x4 (&acc)[2][2][4][2], const pg8::Unit& u, int wr, int wc, int fr, int fq) const {
        const int row0 = row_off + u.pm * 256 + wr * 64 + fr, col0 = u.pn * 256 + wc * 32 + 8 * fq;
#pragma unroll
        for (int ai = 0; ai < 2; ++ai)
#pragma unroll
            for (int m = 0; m < 4; ++m) { GAS bf16_t* rowp = O + (size_t)(row0 + ai * 128 + m * 16) * ldc + col0;
#pragma unroll
                for (int bj = 0; bj < 2; ++bj) { const f32x4 v0 = acc[ai][bj][m][0], v1 = acc[ai][bj][m][1];
                    u32x4 w; w.x = pg8::cvt_pk_bf16(v0[0], v0[1]); w.y = pg8::cvt_pk_bf16(v0[2], v0[3]); w.z = pg8::cvt_pk_bf16(v1[0], v1[1]); w.w = pg8::cvt_pk_bf16(v1[2], v1[3]);
                    *(GAS u32x4*)(rowp + bj * 128) = w; } }
    }
};
struct EpiZ {
    static constexpr bool PERM = true, AFTER_DRAIN = false;
    GAS bf16_t* O; const GAS float* lb;
    __device__ __forceinline__ void operator()(const f32x4 (&acc)[2][2][4][2], const pg8::Unit& u, int wr, int wc, int fr, int fq) const {
        const int row0 = u.pm * 256 + wr * 64 + fr, col0 = u.pn * 256 + wc * 32 + 8 * fq;
        const int ct = u.pn * 256;
        const int mode = (ct >= O_HG && ct < O_HG + 1024) ? 1 : ((ct >= O_HG + 1024 && ct < O_HG + 3072) ? 2 : 0);
        float lbv[2][8];
        if (mode == 2) {
#pragma unroll
            for (int bj = 0; bj < 2; ++bj) { const GAS float* lp = lb + ((col0 + bj * 128) & 1023); const f32x4 a = *(const GAS f32x4*)lp, b = *(const GAS f32x4*)(lp + 4);
#pragma unroll
                for (int j = 0; j < 4; ++j) { lbv[bj][j] = a[j]; lbv[bj][4 + j] = b[j]; } }
        }
#pragma unroll
        for (int ai = 0; ai < 2; ++ai)
#pragma unroll
            for (int m = 0; m < 4; ++m) { GAS bf16_t* rowp = O + (size_t)(row0 + ai * 128 + m * 16) * INW + col0;
#pragma unroll
                for (int bj = 0; bj < 2; ++bj) { const f32x4 v0 = acc[ai][bj][m][0], v1 = acc[ai][bj][m][1];
                    float o[8] = {v0[0], v0[1], v0[2], v0[3], v1[0], v1[1], v1[2], v1[3]};
                    u32x4 w;
                    if (mode == 2) { unsigned hb[8];
#pragma unroll
                        for (int j = 0; j < 8; ++j) { const float z = fminf(fmaxf(o[j], -30.f), 30.f); const float lbj = lbv[bj][j]; const float lf = __builtin_amdgcn_logf(lbj + (1.0f - lbj) * sigm(z));
                            hb[j] = (unsigned)__builtin_bit_cast(unsigned short, (_Float16)lf); }
                        w.x = hb[0] | (hb[1] << 16); w.y = hb[2] | (hb[3] << 16); w.z = hb[4] | (hb[5] << 16); w.w = hb[6] | (hb[7] << 16);
                    } else {
                        if (mode == 1) {
#pragma unroll
                            for (int j = 0; j < 8; ++j) o[j] = o[j] * sigm(o[j]); }
                        w.x = pg8::cvt_pk_bf16(o[0], o[1]); w.y = pg8::cvt_pk_bf16(o[2], o[3]); w.z = pg8::cvt_pk_bf16(o[4], o[5]); w.w = pg8::cvt_pk_bf16(o[6], o[7]);
                    }
                    *(GAS u32x4*)(rowp + bj * 128) = w; } }
    }
};
template <int MODE> struct EpiGate {
    static constexpr bool PERM = true, AFTER_DRAIN = false;
    const GAS bf16_t* Zg; const GAS bf16_t* T; GAS bf16_t* O; int row_off;
    __device__ __forceinline__ void operator()(const f32x4 (&acc)[2][2][4][2], const pg8::Unit& u, int wr, int wc, int fr, int fq) const {
        const int row0 = row_off + u.pm * 256 + wr * 64 + fr, col0 = u.pn * 256 + wc * 32 + 8 * fq;
#pragma unroll
        for (int ai = 0; ai < 2; ++ai) {
            u32x4 gw[4][2], tw[4][2];
#pragma unroll
            for (int m = 0; m < 4; ++m)
#pragma unroll
                for (int bj = 0; bj < 2; ++bj) { const size_t row = (size_t)(row0 + ai * 128 + m * 16); const int col = col0 + bj * 128;
                    gw[m][bj] = *(const GAS u32x4*)(Zg + row * INW + col); if (MODE == 1) tw[m][bj] = *(const GAS u32x4*)(T + row * D + col); }
#pragma unroll
            for (int m = 0; m < 4; ++m)
#pragma unroll
                for (int bj = 0; bj < 2; ++bj) { const size_t row = (size_t)(row0 + ai * 128 + m * 16); const int col = col0 + bj * 128;
                    const u32x4 g4 = gw[m][bj];
                    const f32x4 v0 = acc[ai][bj][m][0], v1 = acc[ai][bj][m][1];
                    float o[8];
                    o[0] = sigm(bflo(g4.x)) * v0[0]; o[1] = sigm(bfhi(g4.x)) * v0[1]; o[2] = sigm(bflo(g4.y)) * v0[2]; o[3] = sigm(bfhi(g4.y)) * v0[3];
                    o[4] = sigm(bflo(g4.z)) * v1[0]; o[5] = sigm(bfhi(g4.z)) * v1[1]; o[6] = sigm(bflo(g4.w)) * v1[2]; o[7] = sigm(bfhi(g4.w)) * v1[3];
                    if (MODE == 1) { const u32x4 t4 = tw[m][bj];
                        o[0] += bflo(t4.x); o[1] += bfhi(t4.x); o[2] += bflo(t4.y); o[3] += bfhi(t4.y); o[4] += bflo(t4.z); o[5] += bfhi(t4.z); o[6] += bflo(t4.w); o[7] += bfhi(t4.w); }
                    u32x4 w; w.x = pg8::cvt_pk_bf16(o[0], o[1]); w.y = pg8::cvt_pk_bf16(o[2], o[3]); w.z = pg8::cvt_pk_bf16(o[4], o[5]); w.w = pg8::cvt_pk_bf16(o[6], o[7]);
                    *(GAS u32x4*)(O + row * D + col) = w; }
        }
    }
};
struct EpiUp {
    static constexpr bool PERM = true, AFTER_DRAIN = false;
    GAS bf16_t* ACT; const GAS float* cw; const GAS float* cb; int pm_off;
    __device__ __forceinline__ void operator()(const f32x4 (&acc)[2][2][4][2], const pg8::Unit& u, int wr, int wc, int fr, int fq) const {
        const int lane = tid_opaque() & 63;
        const int ch0 = u.pn * 128 + wc * 32 + 8 * fq;
        const int pmv = u.pm + pm_off;
        const int lup = (lane & 48) | ((lane + 1) & 15), ldn = (lane & 48) | ((lane - 1) & 15);
        f32x4 cw0[2], cw1[2], cw2[2], cbb[2];
#pragma unroll
        for (int n = 0; n < 2; ++n) { const int chn = ch0 + 4 * n; cw0[n] = *(const GAS f32x4*)(cw + chn); cw1[n] = *(const GAS f32x4*)(cw + DFF + chn); cw2[n] = *(const GAS f32x4*)(cw + 2 * DFF + chn); cbb[n] = *(const GAS f32x4*)(cb + chn); }
#pragma unroll
        for (int ai = 0; ai < 2; ++ai) {
            long drow[4]; bool ok[4];
#pragma unroll
            for (int m = 0; m < 4; ++m) {
                const int r64 = 16 * m + fr; ok[m] = true;
                if (pmv < 10) { const int G = pmv * 4 + ai * 2 + wr, bl = G / 5, gi = G - bl * 5, tok = 62 * gi - 1 + r64; ok[m] = (r64 >= 1) && (r64 <= 62) && (tok < CTX); drow[m] = (long)bl * CTX + tok; }
                else drow[m] = (long)RC + (long)(pmv - 10) * 256 + ai * 128 + wr * 64 + r64;
            }
            unsigned pw[4][4];
#pragma unroll
            for (int n = 0; n < 2; ++n) {
                const f32x4 w0 = cw0[n], w1 = cw1[n], w2 = cw2[n], bb = cbb[n];
#pragma unroll
                for (int jp = 0; jp < 2; ++jp) {
                    float res[2][4];
#pragma unroll
                    for (int jj = 0; jj < 2; ++jj) { const int j = 2 * jp + jj;
                        float ru[4], rd[4];
#pragma unroll
                        for (int m = 0; m < 4; ++m) { const int gi = __float_as_int(acc[ai][0][m][n][j]);
                            ru[m] = __int_as_float(__builtin_amdgcn_update_dpp(0, gi, 0x12F, 0xf, 0xf, false)); rd[m] = __int_as_float(__builtin_amdgcn_update_dpp(0, gi, 0x121, 0xf, 0xf, false)); }
#pragma unroll
                        for (int m = 0; m < 4; ++m) {
                            const float up = (fr < 15) ? ru[m] : (m < 3 ? ru[m < 3 ? m + 1 : 3] : 0.f);
                            const float dn = (fr > 0) ? rd[m] : (m > 0 ? rd[m > 0 ? m - 1 : 0] : 0.f);
                            const float cv = bb[j] + w0[j] * dn + w1[j] * acc[ai][0][m][n][j] + w2[j] * up;
                            res[jj][m] = cv * sigm(cv) * acc[ai][1][m][n][j];
                        } }
#pragma unroll
                    for (int m = 0; m < 4; ++m) pw[m][2 * n + jp] = pg8::cvt_pk_bf16(res[0][m], res[1][m]);
                }
            }
#pragma unroll
            for (int m = 0; m < 4; ++m) if (ok[m]) { u32x4 w; w.x = pw[m][0]; w.y = pw[m][1]; w.z = pw[m][2]; w.w = pw[m][3]; *(GAS u32x4*)(ACT + (size_t)drow[m] * DFF + ch0) = w; }
        }
    }
};

template <bool UPMAP>
__device__ __forceinline__ void conv_item(const GAS float* W, int K, int N, GAS bf16_t* WT, LAS float* scr, int item, int lane) {
    const int nblk = N / 32, kb = item / nblk, nb = item % nblk, k0 = 64 * kb, n0 = 32 * nb;
    float wv[32];
#pragma unroll
    for (int i = 0; i < 32; ++i) { const int kk = 2 * i + (lane >> 5); wv[i] = __builtin_nontemporal_load(W + (size_t)(k0 + kk) * N + n0 + (lane & 31)); }
#pragma unroll
    for (int i = 0; i < 32; ++i) { const int kk = 2 * i + (lane >> 5); scr[kk * 33 + (lane & 31)] = wv[i]; }
    asm volatile("s_waitcnt lgkmcnt(0)" ::: "memory");
    int d0 = n0;
    if (UPMAP) { if (n0 < DFF) d0 = (n0 >> 7) * 256 + (n0 & 127); else { const int n2 = n0 - DFF; d0 = (n2 >> 7) * 256 + 128 + (n2 & 127); } }
    const int c = lane & 7;
#pragma unroll
    for (int j = 0; j < 4; ++j) { const int n = (lane >> 3) + 8 * j; const LAS float* s = scr + (8 * c) * 33 + n;
        u32x4 o; o.x = pk2(s[0 * 33], s[1 * 33]); o.y = pk2(s[2 * 33], s[3 * 33]); o.z = pk2(s[4 * 33], s[5 * 33]); o.w = pk2(s[6 * 33], s[7 * 33]);
        *(GAS u32x4*)(WT + (size_t)(d0 + n) * K + k0 + 8 * c) = o; }
    asm volatile("s_waitcnt lgkmcnt(0)" ::: "memory");
}
struct Ptrs {
    const GAS float*x, *c, *ctx, *c_ctx, *w_ada, *b_ada, *g_pre_mix, *g_post_mix, *g_pre_ffn, *g_post_ffn, *w_in, *rg_conv_w, *rg_conv_b, *rg_wa, *rg_ba, *rg_wx, *rg_bx, *rg_lam,
        *hg_lb, *hg_out_norm, *w_proj_rg, *w_proj_hg, *w_out, *ffn_w_up, *ffn_conv_w, *ffn_conv_b, *ffn_w_down;
    GAS float* out; GAS unsigned char* ws;
};
__device__ __forceinline__ void convert_weights(const Ptrs& P, lptr lds, int l, int part = 0, int skip = 0) {
    const int lane = tid_opaque() & 63, wave = __builtin_amdgcn_readfirstlane(tid_opaque() >> 6);
    LAS float* scr = (LAS float*)(lds + wave * 8448);
    if ((int)blockIdx.x < skip) return;
    const int gw = ((int)blockIdx.x - skip) * 8 + wave, NGW = ((int)gridDim.x - skip) * 8;
    constexpr int I_IN = 16 * 288, I_P = 16 * 32, I_UP = 16 * 176, I_DN = 44 * 32, NIT = I_IN + 3 * I_P + I_UP + I_DN;
    const int it_lo = (part == 2) ? NIT - I_DN : 0, it_hi = (part == 1) ? NIT - I_DN : NIT;
    for (int it = it_lo + gw; it < it_hi; it += NGW) {
        int r = it;
        if (r < I_IN) { conv_item<false>(P.w_in + (size_t)l * D * INW, D, INW, (GAS bf16_t*)(P.ws + WS_WIN), scr, r, lane); continue; } r -= I_IN;
        if (r < I_P) { conv_item<false>(P.w_proj_rg + (size_t)l * D * D, D, D, (GAS bf16_t*)(P.ws + WS_WPRG), scr, r, lane); continue; } r -= I_P;
        if (r < I_P) { conv_item<false>(P.w_proj_hg + (size_t)l * D * D, D, D, (GAS bf16_t*)(P.ws + WS_WPHG), scr, r, lane); continue; } r -= I_P;
        if (r < I_P) { conv_item<false>(P.w_out + (size_t)l * D * D, D, D, (GAS bf16_t*)(P.ws + WS_WOUT), scr, r, lane); continue; } r -= I_P;
        if (r < I_UP) { conv_item<true>(P.ffn_w_up + (size_t)l * D * NUP, D, NUP, (GAS bf16_t*)(P.ws + WS_WUP), scr, r, lane); continue; } r -= I_UP;
        conv_item<false>(P.ffn_w_down + (size_t)l * DFF * D, DFF, D, (GAS bf16_t*)(P.ws + WS_WDN), scr, r, lane);
    }
}
__device__ __forceinline__ void mods_phase(const Ptrs& P, lptr lds) {
    const int tid = tid_opaque(), lane = tid & 63, wave = __builtin_amdgcn_readfirstlane(tid >> 6);
    LAS float* S = (LAS float*)lds;
    LAS float* RED = (LAS float*)(lds + 17 * 1024 * 4);
    GAS float* MOD = (GAS float*)(P.ws + WS_MOD);
    for (int idx = tid; idx < 17 * 1024; idx += NTHREADS) { const int r = idx >> 10, k = idx & 1023; const float v = r < 16 ? P.c[r * 1024 + k] : P.c_ctx[k]; S[idx] = v * sigm(v); }
    if (blockIdx.x == 0) { GAS float* LB = (GAS float*)(P.ws + WS_LB);
        for (int c = tid; c < 1024; c += NTHREADS) { const float p0 = P.hg_lb[c], p1 = P.hg_lb[1024 + c], p2 = P.hg_lb[2048 + c], p3 = P.hg_lb[3072 + c];
            const float mx = fmaxf(fmaxf(p0, p1), fmaxf(p2, p3)); const float e0 = expf(p0 - mx), e1 = expf(p1 - mx), e2 = expf(p2 - mx), e3 = expf(p3 - mx); const float inv = 1.0f / (e0 + e1 + e2 + e3);
            LB[c] = 0.f; LB[1024 + c] = e1 * inv; LB[2048 + c] = (e1 + e2) * inv; LB[3072 + c] = (e1 + e2 + e3) * inv; } }
    __syncthreads();
    for (int task = blockIdx.x; task < 4 * 96; task += gridDim.x) {
        const int l = task / 96, n0 = (task % 96) * 64;
        float acc[17];
#pragma unroll
        for (int r = 0; r < 17; ++r) acc[r] = 0.f;
        const GAS float* wp = P.w_ada + ((size_t)l * 1024 + wave * 128) * 6144 + n0 + lane;
#pragma unroll 4
        for (int kk = 0; kk < 128; ++kk) { const float w = __builtin_nontemporal_load(wp + (size_t)kk * 6144);
#pragma unroll
            for (int r = 0; r < 17; ++r) acc[r] += S[r * 1024 + wave * 128 + kk] * w; }
#pragma unroll
        for (int r = 0; r < 17; ++r) RED[(wave * 17 + r) * 64 + lane] = acc[r];
        __syncthreads();
        for (int idx = tid; idx < 17 * 64; idx += NTHREADS) { const int r = idx >> 6, ln = idx & 63; float s = P.b_ada[l * 6144 + n0 + ln];
#pragma unroll
            for (int w = 0; w < 8; ++w) s += RED[(w * 17 + r) * 64 + ln];
            MOD[(size_t)(l * 17 + r) * 6144 + n0 + ln] = s; }
        __syncthreads();
    }
}
__device__ __forceinline__ const GAS float* modp(const Ptrs& P, int l, int r, int j) { return (const GAS float*)(P.ws + WS_MOD) + ((size_t)(l * 17 + r) * 6 + j) * 1024; }

__device__ __forceinline__ void row_op(const GAS float* xsrc, GAS float* xdst, const GAS bf16_t* y, const GAS float* gate, const GAS float* gpost,
                                       const GAS float* gpre, const GAS float* mscale, const GAS float* mshift, GAS bf16_t* h0, GAS bf16_t* h1, int lane) {
    f32x4 v[4];
#pragma unroll
    for (int j = 0; j < 4; ++j) v[j] = *((const GAS f32x4*)xsrc + lane + 64 * j);
    if (y) {
        f32x4 yy[4]; float ss = 0.f;
#pragma unroll
        for (int j = 0; j < 4; ++j) { const u32x2 w = *((const GAS u32x2*)y + lane + 64 * j); yy[j] = (f32x4){bflo(w.x), bfhi(w.x), bflo(w.y), bfhi(w.y)};
            ss += (yy[j][0] * yy[j][0] + yy[j][1] * yy[j][1]) + (yy[j][2] * yy[j][2] + yy[j][3] * yy[j][3]); }
        const float r = __builtin_amdgcn_rsqf(wave_sum(ss) * (1.0f / 1024.0f) + EPS);
#pragma unroll
        for (int j = 0; j < 4; ++j) { const f32x4 gt = *((const GAS f32x4*)gate + lane + 64 * j), gp = *((const GAS f32x4*)gpost + lane + 64 * j); v[j] = v[j] + gt * (yy[j] * r * gp); }
        if (xdst) {
#pragma unroll
            for (int j = 0; j < 4; ++j) *((GAS f32x4*)xdst + lane + 64 * j) = v[j]; }
    }
    if (h0) {
        float s2 = 0.f;
#pragma unroll
        for (int j = 0; j < 4; ++j) s2 += (v[j][0] * v[j][0] + v[j][1] * v[j][1]) + (v[j][2] * v[j][2] + v[j][3] * v[j][3]);
        const float r2 = __builtin_amdgcn_rsqf(wave_sum(s2) * (1.0f / 1024.0f) + EPS);
#pragma unroll
        for (int j = 0; j < 4; ++j) { const f32x4 gp = *((const GAS f32x4*)gpre + lane + 64 * j), sc = *((const GAS f32x4*)mscale + lane + 64 * j), sh = *((const GAS f32x4*)mshift + lane + 64 * j);
            const f32x4 hv = (v[j] * r2 * gp) * (sc + 1.0f) + sh;
            u32x2 w; w.x = pk2(hv[0], hv[1]); w.y = pk2(hv[2], hv[3]);
            *((GAS u32x2*)h0 + lane + 64 * j) = w; if (h1) *((GAS u32x2*)h1 + lane + 64 * j) = w; }
    }
}
template <int NR, bool HASY, bool HASH>
__device__ __forceinline__ void row_block(const GAS float* xsrc, GAS float* xdst, const GAS bf16_t* y, GAS bf16_t* h, const f32x4 (&A1)[4], const f32x4 (&A2)[4], const f32x4 (&A3)[4], int lane) {
    f32x4 v[NR][4]; f32x4 yy[NR][4]; float ss[NR];
#pragma unroll
    for (int q = 0; q < NR; ++q)
#pragma unroll
        for (int j = 0; j < 4; ++j) v[q][j] = __builtin_nontemporal_load((const GAS f32x4*)(xsrc + (size_t)q * D) + lane + 64 * j);
    if (HASY) {
#pragma unroll
        for (int q = 0; q < NR; ++q) { ss[q] = 0.f;
#pragma unroll
            for (int j = 0; j < 4; ++j) { const u32x2 w = __builtin_nontemporal_load((const GAS u32x2*)(y + (size_t)q * D) + lane + 64 * j); yy[q][j] = (f32x4){bflo(w.x), bfhi(w.x), bflo(w.y), bfhi(w.y)};
                ss[q] += (yy[q][j][0] * yy[q][j][0] + yy[q][j][1] * yy[q][j][1]) + (yy[q][j][2] * yy[q][j][2] + yy[q][j][3] * yy[q][j][3]); } }
#pragma unroll
        for (int o = 1; o < 64; o <<= 1) {
#pragma unroll
            for (int q = 0; q < NR; ++q) ss[q] += __shfl_xor(ss[q], o); }
#pragma unroll
        for (int q = 0; q < NR; ++q) { const float r = __builtin_amdgcn_rsqf(ss[q] * (1.0f / 1024.0f) + EPS);
#pragma unroll
            for (int j = 0; j < 4; ++j) { v[q][j] = v[q][j] + A1[j] * (yy[q][j] * r); __builtin_nontemporal_store(v[q][j], (GAS f32x4*)(xdst + (size_t)q * D) + lane + 64 * j); } }
    }
    if (HASH) {
        float s2[NR];
#pragma unroll
        for (int q = 0; q < NR; ++q) { s2[q] = 0.f;
#pragma unroll
            for (int j = 0; j < 4; ++j) s2[q] += (v[q][j][0] * v[q][j][0] + v[q][j][1] * v[q][j][1]) + (v[q][j][2] * v[q][j][2] + v[q][j][3] * v[q][j][3]); }
#pragma unroll
        for (int o = 1; o < 64; o <<= 1) {
#pragma unroll
            for (int q = 0; q < NR; ++q) s2[q] += __shfl_xor(s2[q], o); }
#pragma unroll
        for (int q = 0; q < NR; ++q) { const float r2 = __builtin_amdgcn_rsqf(s2[q] * (1.0f / 1024.0f) + EPS);
#pragma unroll
            for (int j = 0; j < 4; ++j) { const f32x4 hv = (v[q][j] * r2) * A2[j] + A3[j]; u32x2 w; w.x = pg8::cvt_pk_bf16(hv[0], hv[1]); w.y = pg8::cvt_pk_bf16(hv[2], hv[3]); *((GAS u32x2*)(h + (size_t)q * D) + lane + 64 * j) = w; } }
    }
}
__device__ __forceinline__ void rowop_phase(const Ptrs& P, int kind, int g, int l) {
    const int lane = tid_opaque() & 63, wave = __builtin_amdgcn_readfirstlane(tid_opaque() >> 6);
    const int gw = blockIdx.x * 8 + wave, NGW = gridDim.x * 8;
    GAS bf16_t* H = (GAS bf16_t*)(P.ws + WS_H); const GAS bf16_t* Y = (const GAS bf16_t*)(P.ws + WS_OF); GAS float* XC = (GAS float*)(P.ws + WS_XC);
    for (int blk = gw; blk < RL / 16; blk += NGW) {
        const int rl = blk * 16, b = g * GB + (rl >> 12); const size_t xrow = (size_t)(b * SEQ + (rl & 4095)) * D; const int r = RC + rl;
        const GAS float*pg = nullptr, *pp = nullptr, *pq, *psc, *psh;
        if (kind == 0) { pq = P.g_pre_mix + l * D; psc = modp(P, l, b, 1); psh = modp(P, l, b, 0); }
        else if (kind == 1) { pg = modp(P, l, b, 2); pp = P.g_post_mix + l * D; pq = P.g_pre_ffn + l * D; psc = modp(P, l, b, 4); psh = modp(P, l, b, 3); }
        else { const int ln = l < 3 ? l + 1 : l; pg = modp(P, l, b, 5); pp = P.g_post_ffn + l * D; pq = P.g_pre_mix + ln * D; psc = modp(P, ln, b, 1); psh = modp(P, ln, b, 0); }
        f32x4 A1[4], A2[4], A3[4];
#pragma unroll
        for (int j = 0; j < 4; ++j) { A1[j] = (kind == 0) ? (f32x4){0.f, 0.f, 0.f, 0.f} : *((const GAS f32x4*)pg + lane + 64 * j) * *((const GAS f32x4*)pp + lane + 64 * j);
            A2[j] = *((const GAS f32x4*)pq + lane + 64 * j) * (*((const GAS f32x4*)psc + lane + 64 * j) + 1.0f); A3[j] = *((const GAS f32x4*)psh + lane + 64 * j); }
        if (kind == 0) { for (int i = 0; i < 16; i += 2) row_block<2, false, true>(P.x + xrow + (size_t)i * D, nullptr, nullptr, H + (size_t)(r + i) * D, A1, A2, A3, lane); }
        else if (kind == 1) { const GAS float* xs = (l == 0 ? P.x : P.out) + xrow; for (int i = 0; i < 16; i += 2) row_block<2, true, true>(xs + (size_t)i * D, P.out + xrow + (size_t)i * D, Y + (size_t)(r + i) * D, H + (size_t)(RCX + rl + i) * D, A1, A2, A3, lane); }
        else if (l < 3) { for (int i = 0; i < 16; i += 2) row_block<2, true, true>(P.out + xrow + (size_t)i * D, P.out + xrow + (size_t)i * D, Y + (size_t)(r + i) * D, H + (size_t)(r + i) * D, A1, A2, A3, lane); }
        else { for (int i = 0; i < 16; i += 2) row_block<2, true, false>(P.out + xrow + (size_t)i * D, P.out + xrow + (size_t)i * D, Y + (size_t)(r + i) * D, nullptr, A1, A2, A3, lane); }
    }
    if (kind != 0 && l == 3) return;
    for (int r = gw; r < RC; r += NGW) {
        const int bl = r >> 8, tc = r & 255, b = g * GB + bl, mr = 16; const size_t xrow = (size_t)(b * CTX + tc) * D;
        if (kind == 0) {
            row_op(P.ctx + xrow, nullptr, nullptr, nullptr, nullptr, P.g_pre_mix + l * D, modp(P, l, mr, 1), modp(P, l, mr, 0), H + (size_t)r * D, nullptr, lane);
        } else if (kind == 1) {
            const GAS float* xs = (l == 0 ? P.ctx : XC) + xrow; GAS float* xd = XC + xrow;
            GAS bf16_t*h0, *h1 = nullptr;
            const int gi = tc / 62, rr = tc - gi * 62 + 1; GAS bf16_t* hb = H + (size_t)(bl * 320) * D;
            h0 = hb + (size_t)(gi * 64 + rr) * D;
            if (rr == 62 && gi < 4) h1 = hb + (size_t)((gi + 1) * 64) * D;
            else if (rr == 1 && gi > 0) h1 = hb + (size_t)((gi - 1) * 64 + 63) * D;
            if (tc == 0) { u32x2 zz; zz.x = 0u; zz.y = 0u;
#pragma unroll
                for (int j = 0; j < 4; ++j) *((GAS u32x2*)hb + lane + 64 * j) = zz; }
            if (tc == 255) { u32x2 zz; zz.x = 0u; zz.y = 0u;
                for (int q = 9; q < 64; ++q) {
#pragma unroll
                    for (int j = 0; j < 4; ++j) *((GAS u32x2*)(hb + (size_t)(4 * 64 + q) * D) + lane + 64 * j) = zz; } }
            row_op(xs, xd, Y + (size_t)r * D, modp(P, l, mr, 2), P.g_post_mix + l * D, P.g_pre_ffn + l * D, modp(P, l, mr, 4), modp(P, l, mr, 3), h0, h1, lane);
        } else {
            GAS float* xd = XC + xrow;
            const bool nh = l < 3; const int ln = nh ? l + 1 : l;
            row_op(xd, xd, Y + (size_t)r * D, modp(P, l, mr, 5), P.g_post_ffn + l * D, P.g_pre_mix + ln * D, modp(P, ln, mr, 1), modp(P, ln, mr, 0), nh ? H + (size_t)r * D : nullptr, nullptr, lane);
        }
    }
}
__device__ __forceinline__ void hgout_phase(const Ptrs& P, int l, int skip) {
    const int lane = tid_opaque() & 63, wave = __builtin_amdgcn_readfirstlane(tid_opaque() >> 6);
    if ((int)blockIdx.x < skip) return;
    const int gw = ((int)blockIdx.x - skip) * 8 + wave, NGW = ((int)gridDim.x - skip) * 8;
    GAS bf16_t* OF = (GAS bf16_t*)(P.ws + WS_OF); const GAS bf16_t* OB = (const GAS bf16_t*)(P.ws + WS_OB); const GAS bf16_t* Z = (const GAS bf16_t*)(P.ws + WS_Z);
    const GAS float* gain = P.hg_out_norm + l * D + 16 * lane;
    float gn[16];
#pragma unroll
    for (int q = 0; q < 4; ++q) { const f32x4 t = *((const GAS f32x4*)gain + q); gn[4 * q] = t[0]; gn[4 * q + 1] = t[1]; gn[4 * q + 2] = t[2]; gn[4 * q + 3] = t[3]; }
    for (int r = (l == 3 ? RC : 0) + gw; r < MG; r += NGW) {
        const GAS u32x4* pf = (const GAS u32x4*)(OF + (size_t)r * D + 16 * lane); const GAS u32x4* pb = (const GAS u32x4*)(OB + (size_t)r * D + 16 * lane);
        const GAS u32x4* pg = (const GAS u32x4*)(Z + (size_t)r * INW + O_HG + 4 * 1024 + 16 * lane);
        float o[16], gv[16]; float ss = 0.f;
#pragma unroll
        for (int q = 0; q < 2; ++q) { const u32x4 a = pf[q], b = pb[q], c = pg[q];
            const unsigned aw[4] = {a.x, a.y, a.z, a.w}, bw[4] = {b.x, b.y, b.z, b.w}, cw4[4] = {c.x, c.y, c.z, c.w};
#pragma unroll
            for (int e = 0; e < 4; ++e) { const int i = 8 * q + 2 * e; o[i] = bflo(aw[e]) + bflo(bw[e]); o[i + 1] = bfhi(aw[e]) + bfhi(bw[e]); gv[i] = bflo(cw4[e]); gv[i + 1] = bfhi(cw4[e]); ss += o[i] * o[i] + o[i + 1] * o[i + 1]; } }
        ss += __shfl_xor(ss, 1); ss += __shfl_xor(ss, 2); ss += __shfl_xor(ss, 4);
        const float rr = __builtin_amdgcn_rsqf(ss * (1.0f / 128.0f) + EPS);
        u32x4 w[2];
#pragma unroll
        for (int q = 0; q < 2; ++q) { unsigned pw[4];
#pragma unroll
            for (int e = 0; e < 4; ++e) { const int i = 8 * q + 2 * e; const float y0 = o[i] * rr * gn[i] * (gv[i] * sigm(gv[i])), y1 = o[i + 1] * rr * gn[i + 1] * (gv[i + 1] * sigm(gv[i + 1])); pw[e] = pk2(y0, y1); }
            w[q].x = pw[0]; w[q].y = pw[1]; w[q].z = pw[2]; w[q].w = pw[3]; }
        GAS u32x4* po = (GAS u32x4*)(OF + (size_t)r * D + 16 * lane); po[0] = w[0]; po[1] = w[1];
    }
}
constexpr int HB_QI = 0, HB_KD = 8704, HB_KT = 17408, HB_VT = 27648, HB_E = 32768, HB_SZ = 33280;
constexpr int H_ST = 2 * HB_SZ, H_AM = H_ST + 64 * 272, H_TOT = H_AM + 32 * 80, H_END = H_TOT + 4096;
static_assert(H_END <= 131072, "hg lds");
__device__ __forceinline__ void hg_unit(const Ptrs& P, lptr lds, int l, int u) {
    const int tid = tid_opaque(), lane = tid & 63, wave = __builtin_amdgcn_readfirstlane(tid >> 6), l31 = lane & 31, hh = lane >> 5;
    const int bl = u >> 5, head = (u >> 2) & 7, dir = (u >> 1) & 1, vh = u & 1;
    const GAS bf16_t* Z = (const GAS bf16_t*)(P.ws + WS_Z);
    GAS bf16_t* O = (GAS bf16_t*)(P.ws + (dir ? WS_OB : WS_OF));
    const int kp = tid & 63, tg = tid >> 6;
    const GAS bf16_t* zq = Z + O_HG + head * 128 + 2 * kp;
    const GAS bf16_t* zf = Z + O_HG + (1 + dir) * 1024 + head * 128 + 2 * kp;
    const GAS bf16_t* zv = Z + O_HG + 3 * 1024 + head * 128 + vh * 64 + kp;
    GAS bf16_t* obase = O + head * 128 + vh * 64 + l31;
    for (int i = tid; i < 64 * 272 / 4; i += NTHREADS) *(LAS unsigned*)(lds + H_ST + 4 * i) = 0u;
    f32x16 Sacc;
#pragma unroll
    for (int i = 0; i < 16; ++i) Sacc[i] = 0.f;
    unsigned rq[4], rf[4]; unsigned short rv[4], cv[4];
    f32x2 bc[4], qv[4], kk[4];
#define HG_ROWS(j, rb, rs) long rb, rs; { const int _j = (j); if (_j < 8) { rs = dir ? -1 : 1; rb = (long)bl * CTX + (dir ? 255 - 32 * _j : 32 * _j); } \
        else { const int _m = _j - 8; const int _q0 = dir ? 4095 - 32 * _m : 32 * _m; rs = dir ? -64 : 64; rb = (long)RC + (long)bl * SEQ + (_q0 & 63) * 64 + (_q0 >> 6); } }
#define HG_LOAD(j) do { HG_ROWS(j, _rb, _rs); const long _o0 = (_rb + 4 * tg * _rs) * INW, _st = _rs * INW; \
        _Pragma("unroll") for (int i = 0; i < 4; ++i) { rq[i] = *(const GAS unsigned*)(zq + _o0 + i * _st); rf[i] = *(const GAS unsigned*)(zf + _o0 + i * _st); rv[i] = zv[_o0 + i * _st]; } } while (0)
#define HG_FEAT() do { f32x2 cum; cum.x = 0.f; cum.y = 0.f; _Pragma("unroll") for (int i = 0; i < 4; ++i) { qv[i].x = bflo(rq[i]); qv[i].y = bfhi(rq[i]); \
            f32x2 lf; lf.x = (float)__builtin_bit_cast(_Float16, (unsigned short)(rf[i] & 0xffffu)); lf.y = (float)__builtin_bit_cast(_Float16, (unsigned short)(rf[i] >> 16)); \
            f32x2 ef; ef.x = __builtin_amdgcn_exp2f(lf.x); ef.y = __builtin_amdgcn_exp2f(lf.y); kk[i] = 1.0f - ef; cum = cum + lf; bc[i] = cum; cv[i] = rv[i]; } \
        *(LAS f32x2*)(lds + H_TOT + (tg * 128 + 2 * kp) * 4) = cum; } while (0)
#define HG_WRITE(pb) do { \
        f32x2 off, blt; off.x = 0.f; off.y = 0.f; blt.x = 0.f; blt.y = 0.f; \
        _Pragma("unroll") for (int g2 = 0; g2 < 8; ++g2) { const f32x2 t = *(LAS f32x2*)(lds + H_TOT + (g2 * 128 + 2 * kp) * 4); if (g2 < tg) off = off + t; blt = blt + t; } \
        f32x2 kd[4]; \
        _Pragma("unroll") for (int i = 0; i < 4; ++i) { const int t = 4 * tg + i; const f32x2 b = bc[i] + off; \
            f32x2 e1, e2; e1.x = __builtin_amdgcn_exp2f(b.x); e1.y = __builtin_amdgcn_exp2f(b.y); e2.x = __builtin_amdgcn_exp2f(fminf(-b.x, 100.f)); e2.y = __builtin_amdgcn_exp2f(fminf(-b.y, 100.f)); \
            const f32x2 qi = qv[i] * e1; kd[i] = kk[i] * e2; \
            *(LAS unsigned*)(lds + (pb) + HB_QI + t * 272 + kp * 4) = pg8::cvt_pk_bf16(qi.x, qi.y); \
            *(LAS unsigned*)(lds + (pb) + HB_KD + t * 272 + kp * 4) = pg8::cvt_pk_bf16(kd[i].x, kd[i].y); } \
        { u32x2 w; w.x = pg8::cvt_pk_bf16(kd[0].x, kd[1].x); w.y = pg8::cvt_pk_bf16(kd[2].x, kd[3].x); *(LAS u32x2*)(lds + (pb) + HB_KT + (2 * kp) * 80 + tg * 8) = w; \
          w.x = pg8::cvt_pk_bf16(kd[0].y, kd[1].y); w.y = pg8::cvt_pk_bf16(kd[2].y, kd[3].y); *(LAS u32x2*)(lds + (pb) + HB_KT + (2 * kp + 1) * 80 + tg * 8) = w; } \
        if (tg == 0) { f32x2 e2; e2.x = __builtin_amdgcn_exp2f(blt.x); e2.y = __builtin_amdgcn_exp2f(blt.y); *(LAS f32x2*)(lds + (pb) + HB_E + (2 * kp) * 4) = e2; } \
        { u32x2 w; w.x = (unsigned)cv[0] | ((unsigned)cv[1] << 16); w.y = (unsigned)cv[2] | ((unsigned)cv[3] << 16); *(LAS u32x2*)(lds + (pb) + HB_VT + kp * 80 + tg * 8) = w; } } while (0)
    HG_LOAD(0); HG_FEAT(); HG_LOAD(1);
    LBAR();
    HG_WRITE(0);
    LBAR();
    for (int j = 0; j < 136; ++j) {
        const int pb = (j & 1) * HB_SZ;
        { HG_FEAT(); const int jn = (j + 2 < 136) ? j + 2 : 135; HG_LOAD(jn); }
        f32x16 o0, o1;
#pragma unroll
        for (int i = 0; i < 16; ++i) { o0[i] = 0.f; o1[i] = 0.f; }
        if (wave == 0) {
#pragma unroll
            for (int ks = 0; ks < 8; ks += 2) {
                const bf16x8 a = *(const LAS bf16x8*)(lds + pb + HB_KD + l31 * 272 + 32 * ks + 16 * hh), b = *(const LAS bf16x8*)(lds + pb + HB_QI + l31 * 272 + 32 * ks + 16 * hh);
                const bf16x8 a2 = *(const LAS bf16x8*)(lds + pb + HB_KD + l31 * 272 + 32 * (ks + 1) + 16 * hh), b2 = *(const LAS bf16x8*)(lds + pb + HB_QI + l31 * 272 + 32 * (ks + 1) + 16 * hh);
                o0 = MFMA32(a, b, o0); o1 = MFMA32(a2, b2, o1); }
#pragma unroll
            for (int gq = 0; gq < 4; ++gq) { const int s0 = 8 * gq + 4 * hh; float m[4];
#pragma unroll
                for (int e = 0; e < 4; ++e) m[e] = (s0 + e <= l31) ? (o0[4 * gq + e] + o1[4 * gq + e]) : 0.f;
                u32x2 w; w.x = pg8::cvt_pk_bf16(m[0], m[1]); w.y = pg8::cvt_pk_bf16(m[2], m[3]); *(LAS u32x2*)(lds + H_AM + l31 * 80 + s0 * 2) = w; }
        } else if (wave <= 2) {
            const int vi = wave - 1;
#pragma unroll
            for (int ks = 0; ks < 8; ks += 2) {
                const bf16x8 a = *(const LAS bf16x8*)(lds + pb + HB_QI + l31 * 272 + 32 * ks + 16 * hh), b = *(const LAS bf16x8*)(lds + H_ST + (32 * vi + l31) * 272 + 32 * ks + 16 * hh);
                const bf16x8 a2 = *(const LAS bf16x8*)(lds + pb + HB_QI + l31 * 272 + 32 * (ks + 1) + 16 * hh), b2 = *(const LAS bf16x8*)(lds + H_ST + (32 * vi + l31) * 272 + 32 * (ks + 1) + 16 * hh);
                o0 = MFMA32(a, b, o0); o1 = MFMA32(a2, b2, o1); }
        }
        LBAR();
        if (wave == 1 || wave == 2) {
            const int vi = wave - 1;
            { const bf16x8 a = *(const LAS bf16x8*)(lds + H_AM + l31 * 80 + 16 * hh), b = *(const LAS bf16x8*)(lds + pb + HB_VT + (32 * vi + l31) * 80 + 16 * hh); o0 = MFMA32(a, b, o0); }
            { const bf16x8 a = *(const LAS bf16x8*)(lds + H_AM + l31 * 80 + 32 + 16 * hh), b = *(const LAS bf16x8*)(lds + pb + HB_VT + (32 * vi + l31) * 80 + 32 + 16 * hh); o1 = MFMA32(a, b, o1); }
            HG_ROWS(j, rb, rs);
            GAS bf16_t* op = obase + 32 * vi + (rb + 4 * hh * rs) * D; const long ost = rs * D;
#pragma unroll
            for (int r = 0; r < 16; r += 2) { const int t = (r & 3) + 8 * (r >> 2); const unsigned w = pg8::cvt_pk_bf16(o0[r] + o1[r], o0[r + 1] + o1[r + 1]); op[t * ost] = (bf16_t)(w & 0xffffu); op[(t + 1) * ost] = (bf16_t)(w >> 16); }
        }
        { const int ki = wave & 3, vi2 = wave >> 2;
#pragma unroll
          for (int ks = 0; ks < 2; ++ks) { const bf16x8 a = *(const LAS bf16x8*)(lds + pb + HB_KT + (32 * ki + l31) * 80 + 32 * ks + 16 * hh), b = *(const LAS bf16x8*)(lds + pb + HB_VT + (32 * vi2 + l31) * 80 + 32 * ks + 16 * hh); Sacc = MFMA32(a, b, Sacc); }
#pragma unroll
          for (int gq = 0; gq < 4; ++gq) { const f32x4 e4 = *(const LAS f32x4*)(lds + pb + HB_E + (32 * ki + 8 * gq + 4 * hh) * 4);
#pragma unroll
              for (int e = 0; e < 4; ++e) Sacc[4 * gq + e] *= e4[e];
              u32x2 w; w.x = pg8::cvt_pk_bf16(Sacc[4 * gq], Sacc[4 * gq + 1]); w.y = pg8::cvt_pk_bf16(Sacc[4 * gq + 2], Sacc[4 * gq + 3]);
              *(LAS u32x2*)(lds + H_ST + (32 * vi2 + l31) * 272 + (32 * ki + 8 * gq + 4 * hh) * 2) = w; } }
        { const int pn = ((j + 1) & 1) * HB_SZ; HG_WRITE(pn); }
        LBAR();
    }
#undef HG_LOAD
#undef HG_FEAT
#undef HG_WRITE
#undef HG_ROWS
}

constexpr int RT = 256, TPT = RT / 16, RNC = CTX / RT, RNL = SEQ / RT, RNT = RNC + RNL;
constexpr int RXB = 0, RXF = RXB + RT * 144, RAA = RXF + RT * 128, RBB = RAA + RT * 128, RCAR = RBB + RT * 128, RCARRY = RCAR + 16 * 32 * 8, RWF = RCARRY + 256, RCW = RWF + 8 * 1024, REND = RCW + 32 * 48;
static_assert(REND <= XB_LDS_OFF, "rg lds");
typedef float f32x4v __attribute__((ext_vector_type(4)));
#define MFMA16(a, b, c) __builtin_amdgcn_mfma_f32_16x16x32_bf16((a), (b), (c), 0, 0, 0)
__device__ __forceinline__ void rg_unit(const Ptrs& P, lptr lds, int l, int u) {
    const int tid = tid_opaque(), lane = tid & 63, wave = __builtin_amdgcn_readfirstlane(tid >> 6), l15 = lane & 15, q4 = lane >> 4;
    const int bl = u >> 5, head = (u >> 1) & 15, hf = u & 1;
    const int c0 = head * 64;
    const GAS bf16_t* Z = (const GAS bf16_t*)(P.ws + WS_Z);
    GAS bf16_t* R0 = (GAS bf16_t*)(P.ws + WS_R0);
    const int cp = tid & 31, tg = tid >> 5;
    float cwv[2][4], cbv[2];
#pragma unroll
    for (int e = 0; e < 2; ++e) { cbv[e] = P.rg_conv_b[l * 1024 + c0 + 2 * cp + e];
#pragma unroll
        for (int jj = 0; jj < 4; ++jj) cwv[e][jj] = P.rg_conv_w[(l * 4 + jj) * 1024 + c0 + 2 * cp + e]; }
    LBAR();
    if (tid < 32) {
#pragma unroll
        for (int e = 0; e < 2; ++e) { *(LAS float*)(lds + RCW + cp * 48 + (e * 5 + 4) * 4) = cbv[e];
#pragma unroll
            for (int jj = 0; jj < 4; ++jj) *(LAS float*)(lds + RCW + cp * 48 + (e * 5 + jj) * 4) = cwv[e][jj]; } }
    const int sc = tid & 31, sub = tid >> 5;
    const int mych = c0 + 32 * hf + sc;
    const GAS bf16_t* zx = Z + O_RGX + c0 + 2 * cp;
    const GAS bf16_t* zg = Z + O_RGG + mych;
    GAS bf16_t* rp = R0 + mych;
#pragma unroll
    for (int d = 0; d < 2; ++d) {
        float c8l[2], bal[2], bxl[2];
        LBAR();
#pragma unroll
        for (int nt = 0; nt < 2; ++nt) {
            const size_t wb = ((size_t)((l * 2 + d) * 16 + head) * 64) * 64 + 32 * hf + 16 * nt + l15;
            float fa[2][8], fx[2][8];
#pragma unroll
            for (int ks = 0; ks < 2; ++ks)
#pragma unroll
                for (int e = 0; e < 8; ++e) { const int i0 = 32 * ks + 8 * q4 + e; fa[ks][e] = P.rg_wa[wb + (size_t)i0 * 64]; fx[ks][e] = P.rg_wx[wb + (size_t)i0 * 64]; }
#pragma unroll
            for (int ks = 0; ks < 2; ++ks) { u32x4 t;
                t.x = pk2(fa[ks][0], fa[ks][1]); t.y = pk2(fa[ks][2], fa[ks][3]); t.z = pk2(fa[ks][4], fa[ks][5]); t.w = pk2(fa[ks][6], fa[ks][7]); if (wave == 0) *(LAS u32x4*)(lds + RWF + ((0 * 2 + nt) * 2 + ks) * 1024 + lane * 16) = t;
                t.x = pk2(fx[ks][0], fx[ks][1]); t.y = pk2(fx[ks][2], fx[ks][3]); t.z = pk2(fx[ks][4], fx[ks][5]); t.w = pk2(fx[ks][6], fx[ks][7]); if (wave == 0) *(LAS u32x4*)(lds + RWF + ((1 * 2 + nt) * 2 + ks) * 1024 + lane * 16) = t; }
            const int gch = (l * 2 + d) * 1024 + c0 + 32 * hf + 16 * nt + l15;
            c8l[nt] = 8.0f * 1.4426950408889634f * log1pf(expf(-P.rg_lam[gch]));
            bal[nt] = P.rg_ba[gch]; bxl[nt] = P.rg_bx[gch];
        }
#define RG_TILE(n, t0, rbase, len) int t0, len; long rbase; { const int _n = (n); if (_n < RNC) { t0 = RT * (d ? RNC - 1 - _n : _n); len = CTX; rbase = (long)bl * CTX; } else { t0 = RT * (d ? RNT - 1 - _n : _n - RNC); len = SEQ; rbase = (long)RC + (long)bl * SEQ; } }
        unsigned zr[TPT + 3]; unsigned zvalid = 0u;
#define RG_LOAD(n) do { RG_TILE(n, _t0, _rb, _len); const int _ts = _t0 + TPT * tg - 1; const GAS bf16_t* _p = zx + (_rb + _ts) * INW; \
        _Pragma("unroll") for (int i = 0; i < TPT + 3; ++i) zr[i] = *(const GAS unsigned*)(_p + (long)i * INW);     \
        zvalid = 0u; _Pragma("unroll") for (int i = 0; i < TPT + 3; ++i) { const int _t = _ts + i; if (_t >= 0 && _t < _len) zvalid |= (1u << i); } } while (0)
#define RG_CONV() do { float cwv[2][4], cbv[2]; _Pragma("unroll") for (int e = 0; e < 2; ++e) { cbv[e] = *(const LAS float*)(lds + RCW + cp * 48 + (e * 5 + 4) * 4); \
            _Pragma("unroll") for (int jj = 0; jj < 4; ++jj) cwv[e][jj] = *(const LAS float*)(lds + RCW + cp * 48 + (e * 5 + jj) * 4); } \
        _Pragma("unroll") for (int i = 0; i < TPT + 3; ++i) zr[i] = ((zvalid >> i) & 1u) ? zr[i] : 0u; \
        _Pragma("unroll") for (int i = 0; i < TPT; ++i) { \
            const float x0 = cbv[0] + cwv[0][0] * bflo(zr[i]) + cwv[0][1] * bflo(zr[i + 1]) + cwv[0][2] * bflo(zr[i + 2]) + cwv[0][3] * bflo(zr[i + 3]); \
            const float x1 = cbv[1] + cwv[1][0] * bfhi(zr[i]) + cwv[1][1] * bfhi(zr[i + 1]) + cwv[1][2] * bfhi(zr[i + 2]) + cwv[1][3] * bfhi(zr[i + 3]); \
            const int tt = TPT * tg + i; *(LAS unsigned*)(lds + RXB + tt * 144 + cp * 4) = pg8::cvt_pk_bf16(x0, x1); \
            } } while (0)
#define RG_GATES() do { _Pragma("unroll") for (int mb = 0; mb < 2; ++mb) { f32x4v ga[2], gx[2]; _Pragma("unroll") for (int nt = 0; nt < 2; ++nt) { ga[nt] = (f32x4v){0.f, 0.f, 0.f, 0.f}; gx[nt] = (f32x4v){0.f, 0.f, 0.f, 0.f}; } \
        _Pragma("unroll") for (int ks = 0; ks < 2; ++ks) { const bf16x8 af = *(const LAS bf16x8*)(lds + RXB + (32 * wave + 16 * mb + l15) * 144 + 64 * ks + 16 * q4); \
            _Pragma("unroll") for (int nt = 0; nt < 2; ++nt) { ga[nt] = MFMA16(af, *(const LAS bf16x8*)(lds + RWF + ((0 * 2 + nt) * 2 + ks) * 1024 + lane * 16), ga[nt]); gx[nt] = MFMA16(af, *(const LAS bf16x8*)(lds + RWF + ((1 * 2 + nt) * 2 + ks) * 1024 + lane * 16), gx[nt]); } } \
        _Pragma("unroll") for (int nt = 0; nt < 2; ++nt) _Pragma("unroll") for (int r = 0; r < 4; ++r) { const int tt = 32 * wave + 16 * mb + 4 * q4 + r, cc = 16 * nt + l15; \
            const float xv = bf1(*(const LAS unsigned short*)(lds + RXB + tt * 144 + (32 * hf + cc) * 2));     \
            const float la = -c8l[nt] * sigm(ga[nt][r] + bal[nt]); const float av = __builtin_amdgcn_exp2f(la); \
            const float bv = __builtin_amdgcn_sqrtf(fmaxf(1.0f - av * av, 0.f)) * sigm(gx[nt][r] + bxl[nt]) * xv; \
            *(LAS float*)(lds + RAA + tt * 128 + cc * 4) = av; *(LAS float*)(lds + RBB + tt * 128 + cc * 4) = bv; } } } while (0)
        LBAR();
        if (tid < 32) *(LAS float*)(lds + RCARRY + tid * 4) = 0.f;
        RG_LOAD(0); RG_CONV(); RG_LOAD(1);
        LBAR();
        RG_GATES();
        LBAR();
        for (int n = 0; n < RNT; ++n) {
            RG_TILE(n, t0, rbase, len); (void)len;
            float av[TPT], bv[TPT]; float Pp = 1.f, Hl = 0.f;
#pragma unroll
            for (int ii = 0; ii < TPT; ++ii) { const int i = d ? TPT - 1 - ii : ii; const int tt = TPT * sub + i;
                const float a = *(LAS float*)(lds + RAA + tt * 128 + sc * 4), b = *(LAS float*)(lds + RBB + tt * 128 + sc * 4);
                av[ii] = a; bv[ii] = b; Hl = a * Hl + b; Pp *= a; }
            { f32x2 ph; ph.x = Pp; ph.y = Hl; *(LAS f32x2*)(lds + RCAR + (sub * 32 + sc) * 8) = ph; }
            unsigned gp[TPT / 2], hp[TPT / 2];
            if (d == 1) {
#pragma unroll
                for (int k2 = 0; k2 < TPT / 2; ++k2) { const long ra = rbase + t0 + TPT * sub + (TPT - 1 - 2 * k2), rb2 = ra - 1;
                    gp[k2] = (unsigned)zg[ra * INW] | ((unsigned)zg[rb2 * INW] << 16); hp[k2] = (unsigned)rp[ra * D] | ((unsigned)rp[rb2 * D] << 16); }
            }
            { RG_CONV(); const int nn = (n + 2 < RNT) ? n + 2 : RNT - 1; RG_LOAD(nn); }
            LBAR();
            float hin = *(LAS float*)(lds + RCARRY + ((n & 1) * 32 + sc) * 4);
#pragma unroll 4
            for (int idx = 0; idx < 16; ++idx) { const int s2 = d ? 15 - idx : idx; const f32x2 ph = *(LAS f32x2*)(lds + RCAR + (s2 * 32 + sc) * 8);
                const bool use = d ? (s2 > sub) : (s2 < sub); hin = use ? ph.x * hin + ph.y : hin; }
#pragma unroll
            for (int ii = 0; ii < TPT; ii += 2) { float o2[2];
#pragma unroll
                for (int e = 0; e < 2; ++e) { hin = av[ii + e] * hin + bv[ii + e];
                    if (d == 0) o2[e] = hin;
                    else { const float gg = e ? bfhi(gp[ii / 2]) : bflo(gp[ii / 2]); const float hf2 = e ? bfhi(hp[ii / 2]) : bflo(hp[ii / 2]);
                           const float uu = 1.5957691216057308f * (gg + 0.044715f * gg * gg * gg);
                           o2[e] = gg * sigm(uu) * (hf2 + hin); } }
                const unsigned w = pg8::cvt_pk_bf16(o2[0], o2[1]);
                const long ro0 = rbase + t0 + TPT * sub + (d ? TPT - 1 - ii : ii), ro1 = rbase + t0 + TPT * sub + (d ? TPT - 2 - ii : ii + 1);
                rp[ro0 * D] = (bf16_t)(w & 0xffffu); rp[ro1 * D] = (bf16_t)(w >> 16); }
            if ((d == 0 && sub == 15) || (d == 1 && sub == 0)) *(LAS float*)(lds + RCARRY + (((n + 1) & 1) * 32 + sc) * 4) = hin;
            { RG_GATES(); }
            LBAR();
        }
#undef RG_TILE
#undef RG_LOAD
#undef RG_CONV
#undef RG_GATES
    }
}

#define XB_TMO      128
#define XB_XCNT(j)  (256  + 64 * (j))
#define XB_XSUB(j)  (1280 + 64 * (j))
#define XB_XGEN(j)  (2304 + 64 * (j))
#define XB_TOP      3328
#define XB_TOPGEN   3392
#define XCD_BAR_WORDS 3456
#define XB_SPIN_CAP (1u << 18)

__device__ __forceinline__ unsigned xb_ld(unsigned* p)              { return __hip_atomic_load(p, __ATOMIC_RELAXED, __HIP_MEMORY_SCOPE_AGENT); }
__device__ __forceinline__ unsigned xb_add(unsigned* p, unsigned v) { return __hip_atomic_fetch_add(p, v, __ATOMIC_RELAXED, __HIP_MEMORY_SCOPE_AGENT); }
__device__ __forceinline__ unsigned xb_xcc_id() { return (unsigned)__builtin_amdgcn_s_getreg((3 << 11) | 20) & 0xFu; }
#define XB_SPIN(cond, bar) do { unsigned _sp = 0; while (cond) { __builtin_amdgcn_s_sleep(1); \
    if ((++_sp & 255u) == 0u) { if (xb_ld(&(bar)[XB_TMO])) break; if (_sp > XB_SPIN_CAP) { atomicAdd(&(bar)[XB_TMO], 1u); break; } } } } while (0)

struct XcdBarrier {
    unsigned* bar; unsigned x;
    volatile LAS unsigned* st;
};

__device__ __forceinline__ XcdBarrier xcd_barrier_post(unsigned* bar, volatile LAS unsigned* st) {
    XcdBarrier b; b.bar = bar; b.x = xb_xcc_id(); b.st = st;
    if (tid_opaque() == 0) (void)xb_add(&bar[XB_XCNT(b.x)], 1u);
    return b;
}
__device__ __forceinline__ void xcd_barrier_complete(unsigned* bar, unsigned x, unsigned& nloc, unsigned& nx) {
    const unsigned G = gridDim.x * gridDim.y * gridDim.z;
    unsigned sum, cnt, mine, sp = 0u;
    for (;;) {
        sum = 0u; cnt = 0u; mine = 0u;
#pragma unroll
        for (unsigned j = 0; j < 16; ++j) { const unsigned c = xb_ld(&bar[XB_XCNT(j)]); sum += c; cnt += (c > 0u) ? 1u : 0u; mine = (j == x) ? c : mine; }
        if (sum == G) break;
        __builtin_amdgcn_s_sleep(1);
        if ((++sp & 255u) == 0u) { if (xb_ld(&bar[XB_TMO])) break; if (sp > XB_SPIN_CAP) { atomicAdd(&bar[XB_TMO], 1u); break; } }
    }
    nloc = mine > 0u ? mine : 1u; nx = cnt > 0u ? cnt : 1u;
}

__device__ __forceinline__ void xcd_barrier(const XcdBarrier& b) {
    asm volatile("s_waitcnt vmcnt(0)" ::: "memory");
    __syncthreads();
    if (tid_opaque() == 0) {
        unsigned* bar = b.bar;
        __builtin_amdgcn_s_waitcnt(0);
        unsigned nloc = b.st[0], nx = b.st[1];
        if (nloc == 0u) { xcd_barrier_complete(bar, b.x, nloc, nx); b.st[0] = nloc; b.st[1] = nx; }
        const unsigned old = xb_add(&bar[XB_XSUB(b.x)], 1u);
        const unsigned gen = old / nloc;
        if (old + 1u == (gen + 1u) * nloc) {
            __builtin_amdgcn_fence(__ATOMIC_RELEASE, "agent");
            asm volatile("s_waitcnt vmcnt(0)" ::: "memory");
            const unsigned og = xb_add(&bar[XB_TOP], 1u);
            const unsigned tg = og / nx;
            if (og + 1u == (tg + 1u) * nx) xb_add(&bar[XB_TOPGEN], 1u);
            else XB_SPIN(xb_ld(&bar[XB_TOPGEN]) == tg, bar);
            __builtin_amdgcn_fence(__ATOMIC_ACQUIRE, "agent");
            xb_add(&bar[XB_XGEN(b.x)], 1u);
            asm volatile("s_waitcnt vmcnt(0)" ::: "memory");
        } else {
            XB_SPIN(xb_ld(&bar[XB_XGEN(b.x)]) == gen, bar);
            __builtin_amdgcn_fence(__ATOMIC_ACQUIRE, "agent");
            asm volatile("s_waitcnt vmcnt(0)" ::: "memory");
        }
    }
    __syncthreads();
}

struct Args { Ptrs p; int lo, hi; };
__global__ void __launch_bounds__(NTHREADS, 2) mega_fwd(Args args) {
    extern __shared__ __attribute__((aligned(16))) unsigned char lds_raw[];
    cg::grid_group grid = cg::this_grid();
    lptr lds = (lptr)lds_raw;
    const int lo = args.lo, hi = args.hi;
    typedef const Args __attribute__((address_space(4)))* kargp_t;
#define KP() ({ kargp_t _p = (kargp_t)__builtin_amdgcn_kernarg_segment_ptr(); asm volatile("" : "+s"(_p)); _p; })
#define GETP() Ptrs P; { kargp_t _kp = KP(); const unsigned long long* _src = (const unsigned long long*)_kp; unsigned long long* _dst = (unsigned long long*)&P; _Pragma("unroll") for (int _i = 0; _i < 29; ++_i) _dst[_i] = _src[_i]; } GAS unsigned char* ws = P.ws;
    int ph = 0;
    { volatile LAS unsigned* st0 = (volatile LAS unsigned*)(lds + XB_LDS_OFF); if (tid_opaque() < 2) st0[tid_opaque()] = 0u; }
    __syncthreads();
    XcdBarrier xbar = xcd_barrier_post((unsigned*)args.p.ws, (volatile LAS unsigned*)(lds + XB_LDS_OFF));
#define RUN (ph >= lo && ph < hi)
#define SEAM() do { ++ph; if (ph > lo && ph < hi) { if (ph == 1) grid.sync(); else xcd_barrier(xbar); } } while (0)
#define BUFS() GAS bf16_t* H = (GAS bf16_t*)(ws + WS_H); GAS bf16_t* R0 = (GAS bf16_t*)(ws + WS_R0); GAS bf16_t* OF = (GAS bf16_t*)(ws + WS_OF); GAS bf16_t* OB = (GAS bf16_t*)(ws + WS_OB); GAS bf16_t* Z = (GAS bf16_t*)(ws + WS_Z); GAS bf16_t* ACT = Z; (void)H; (void)R0; (void)OF; (void)OB; (void)ACT;
    const int G = gridDim.x, bid = blockIdx.x;

    if (RUN) { GETP(); BUFS(); mods_phase(P, lds); __syncthreads(); convert_weights(P, lds, 0); }
    SEAM();
    if (RUN) { GETP(); BUFS(); rowop_phase(P, 0, 0, 0); }
    SEAM();
    for (int g = 0; g < NGRP; ++g) {
        for (int l = 0; l < DEPTH; ++l) {
            const bool last = (l == DEPTH - 1);
            const int roff = last ? RC : 0, Mm = last ? RL : MG;
            if (RUN) { GETP(); BUFS(); pg8::Gemm gm{(const bf16_t*)(H), (const bf16_t*)(ws + WS_WIN), MG, INW, D}; pg8::StaticOrder S; S.init(MG, INW, G, bid); EpiZ E{Z, (const GAS float*)(ws + WS_LB) + l * 1024}; pg8::gemm_phase<EpiZ, pg8::StaticOrder>(lds, gm, S, E); }
            SEAM();
            if (RUN) { GETP(); BUFS(); const int vb = (G % 8 == 0) ? (bid % 8) * (G / 8) + bid / 8 : bid;
                       for (int u = vb; u < 256; u += G) hg_unit(P, lds, l, u);
                       for (int u = vb; u < 256; u += G) rg_unit(P, lds, l, u); }
            SEAM();
            if (RUN) { GETP(); BUFS(); pg8::StaticOrder S; S.init(Mm, D, G, bid);
                { pg8::Gemm gm{(const bf16_t*)(R0 + (size_t)roff * D), (const bf16_t*)(ws + WS_WPRG), Mm, D, D}; EpiGate<0> E{Z + O_GA, nullptr, H, roff}; pg8::gemm_phase<EpiGate<0>, pg8::StaticOrder>(lds, gm, S, E); }
                const int nun = (Mm / 256) * (D / 256); const int extra = (nun % G != 0 && G > 64) ? (nun % G) : 0;
                hgout_phase(P, l, extra <= G / 2 ? extra : 0); }
            SEAM();
            if (RUN) { GETP(); BUFS(); pg8::StaticOrder S; S.init(Mm, D, G, bid);
                { pg8::Gemm gm{(const bf16_t*)(OF + (size_t)roff * D), (const bf16_t*)(ws + WS_WPHG), Mm, D, D}; EpiGate<1> E{Z + O_GB, H, OB, roff}; pg8::gemm_phase<EpiGate<1>, pg8::StaticOrder>(lds, gm, S, E); } }
            SEAM();
            if (RUN) { GETP(); BUFS(); pg8::Gemm gm{(const bf16_t*)(OB + (size_t)roff * D), (const bf16_t*)(ws + WS_WOUT), Mm, D, D}; pg8::StaticOrder S; S.init(Mm, D, G, bid); EpiStore E{OF, D, roff}; pg8::gemm_phase<EpiStore, pg8::StaticOrder>(lds, gm, S, E); }
            SEAM();
            if (RUN) { GETP(); BUFS(); rowop_phase(P, 1, g, l); }
            SEAM();
            if (RUN) { GETP(); BUFS(); const int xoff = last ? RCX : 0, Mu = last ? RL : MGX;
                pg8::Gemm gm{(const bf16_t*)(H + (size_t)xoff * D), (const bf16_t*)(ws + WS_WUP), Mu, NUP, D}; pg8::StaticOrder S; S.init(Mu, NUP, G, bid);
                EpiUp E{ACT, P.ffn_conv_w + (size_t)l * 3 * DFF, P.ffn_conv_b + (size_t)l * DFF, last ? 10 : 0}; pg8::gemm_phase<EpiUp, pg8::StaticOrder>(lds, gm, S, E); }
            SEAM();
            if (RUN) { GETP(); BUFS(); pg8::Gemm gm{(const bf16_t*)(ACT + (size_t)roff * DFF), (const bf16_t*)(ws + WS_WDN), Mm, D, DFF}; pg8::StaticOrder S; S.init(Mm, D, G, bid); EpiStore E{OF, D, roff}; pg8::gemm_phase<EpiStore, pg8::StaticOrder>(lds, gm, S, E);
                const int nun = (Mm / 256) * (D / 256); const int extra = (nun % G != 0 && G > 64 && (nun % G) <= G / 2) ? (nun % G) : 0;
                LBAR();
                if (!last) convert_weights(P, lds, l + 1, 1, extra); else if (g + 1 < NGRP) convert_weights(P, lds, 0, 1, extra); }
            SEAM();
            if (RUN) { GETP(); BUFS(); rowop_phase(P, 2, g, l);
                if (!last) convert_weights(P, lds, l + 1, 2);
                else if (g + 1 < NGRP) { convert_weights(P, lds, 0, 2); rowop_phase(P, 0, g + 1, 0); } }
            SEAM();
        }
    }
#undef RUN
#undef SEAM
}
constexpr int N_PHASES = 2 + NGRP * DEPTH * 9;

extern "C" void kernel_launch(void* const* d_in, const int* in_sizes, int n_in, void* d_out, int out_size, void* d_ws, size_t ws_size, hipStream_t stream) {
    static int grid = 0;
    if (grid == 0) {
        if (n_in != 27 || ws_size < WS_END) { fprintf(stderr, "kernel_launch: unexpected n_in %d or ws_size %zu (< %zu)\n", n_in, ws_size, (size_t)WS_END); grid = -1; return; }
        int dev = 0, cus = 0, per_cu = 0;
        (void)hipGetDevice(&dev);
        (void)hipDeviceGetAttribute(&cus, hipDeviceAttributeMultiprocessorCount, dev);
        if (hipFuncSetAttribute((const void*)mega_fwd, hipFuncAttributeMaxDynamicSharedMemorySize, LDS_BYTES) != hipSuccess) { fprintf(stderr, "kernel_launch: hipFuncSetAttribute failed\n"); grid = -1; return; }
        if (hipOccupancyMaxActiveBlocksPerMultiprocessor(&per_cu, (const void*)mega_fwd, NTHREADS, LDS_BYTES) != hipSuccess || per_cu < 1) { fprintf(stderr, "kernel_launch: occupancy query says %d\n", per_cu); per_cu = 1; }
        (void)hipGetLastError();
        grid = cus * 1;
        fprintf(stderr, "kernel_launch: cus %d per_cu %d grid %d\n", cus, per_cu, grid);
    }
    if (grid < 0) return;
    if (hipMemsetAsync(d_ws, 0, 65536, stream) != hipSuccess) { fprintf(stderr, "kernel_launch: memset failed\n"); return; }
    Args a{};
    const GAS float** pp = (const GAS float**)&a.p;
    for (int i = 0; i < 27; ++i) pp[i] = (const GAS float*)d_in[i];
    a.p.out = (GAS float*)d_out; a.p.ws = (GAS unsigned char*)d_ws;
#ifdef MULTI_LAUNCH
    for (int p = 0; p < N_PHASES; ++p) { a.lo = p; a.hi = p + 1; hipLaunchKernelGGL(mega_fwd, dim3(grid), dim3(NTHREADS), LDS_BYTES, stream, a); }
#else
    a.lo = 0; a.hi = N_PHASES;
    void* kargs[] = {&a};
    hipError_t e = hipLaunchCooperativeKernel((void*)mega_fwd, dim3(grid), dim3(NTHREADS), kargs, LDS_BYTES, stream);
    if (e != hipSuccess) fprintf(stderr, "cooperative launch failed: %s (grid %d)\n", hipGetErrorString(e), grid);
#endif
}
```

```cpp
#include <hip/hip_runtime.h>
#include <hip/hip_cooperative_groups.h>
#include <cstdio>
namespace cg = cooperative_groups;
__device__ __forceinline__ int tid_opaque() { int t = threadIdx.x; asm volatile("" : "+v"(t)); return t; }
namespace pg8 {
#define PG8_LAS __attribute__((address_space(3)))
typedef unsigned short bf16_t;
typedef short bf16x8 __attribute__((ext_vector_type(8)));
typedef float f32x4 __attribute__((ext_vector_type(4)));
typedef unsigned u32x4 __attribute__((ext_vector_type(4)));
constexpr int BM = 256, BK = 64, HALF = 128, HTB = HALF * BK * 2  , STAGE_BYTES = 8 * HTB, NXCD = 8, WGM = 8;

__host__ __device__ __forceinline__ int lds_byte(int r, int c) { const int st = (r >> 4) * 2 + (c >> 5), rr = r & 15, cc = c & 31, ob = rr * 64 + cc * 2; return st * 1024 + (ob ^ (((ob >> 9) & 1) << 5)); }
__host__ __device__ __forceinline__ void stage_rc(int b, int& R, int& C) { const int st = b / 1024, sb = b % 1024, swz = sb ^ (((sb >> 9) & 1) << 5); R = (st >> 1) * 16 + swz / 64; C = (st & 1) * 32 + (swz % 64) / 2; }
__host__ __device__ __forceinline__ int perm32(int rho) { const int n = rho >> 4, i = rho & 15; return 8 * (i >> 2) + 4 * n + (i & 3); }

struct Unit { int pm, pn; };
struct Gemm { const bf16_t* A; const bf16_t* Bt; int M, N, K; };

struct StaticOrder {
    int nM, nN, nwg, G, c;
    __host__ __device__ void init(int M, int N, int G_, int c_) { nM = M / BM; nN = N / BM; nwg = nM * nN; G = G_; c = c_; }
    __host__ __device__ bool next(int i, Unit& u) const {
        const long L = (long)i * G + c; if (L >= nwg) return false;
        int wgid = (int)L; { const int q = nwg / NXCD, r = nwg % NXCD, xcd = wgid % NXCD, off = wgid / NXCD; wgid = (xcd < r ? xcd * (q + 1) : r * (q + 1) + (xcd - r) * q) + off; }
        const int nig = WGM * nN, gid = wgid / nig, fm = gid * WGM, gsz = (nM - fm) < WGM ? (nM - fm) : WGM;
        u.pm = fm + ((wgid % nig) % gsz); u.pn = (wgid % nig) / gsz; return true;
    }
    __device__ __forceinline__ void a_ready(const Unit&) const {}
    __device__ __forceinline__ void done(const Unit&) const {}
};
__device__ __forceinline__ unsigned cvt_pk_bf16(float lo, float hi) { unsigned r; asm volatile("v_cvt_pk_bf16_f32 %0, %1, %2" : "=v"(r) : "v"(lo), "v"(hi)); return r; }
template <class Epi, class Sched>
__device__ __forceinline__ void gemm_phase(PG8_LAS unsigned char* lds, const Gemm g, const Sched& S, const Epi& E) {
    const int tid = tid_opaque(), wid = __builtin_amdgcn_readfirstlane(tid >> 6), lane = tid & 63, wr = wid >> 2, wc = wid & 3, fr = lane & 15, fq = lane >> 4;
    const int K = g.K, nt = K / BK;
    unsigned voffA[2], voffB[2];
#pragma unroll
    for (int i = 0; i < 2; ++i) { int R, C; stage_rc(tid * 16 + i * 8192, R, C); const int Rb = Epi::PERM ? ((R & ~31) + perm32(R & 31)) : R;
        voffA[i] = (unsigned)(R * K + C) * 2u; voffB[i] = (unsigned)(Rb * K + C) * 2u; }
    const size_t kstep = (size_t)(BK * 2);
    const size_t hstep = (size_t)HALF * K * 2;
    const size_t tstep = 2 * hstep;
    const unsigned ldsw = (unsigned)wid * 1024u;
    const int aoff = lds_byte(wr * 64 + fr, fq * 8), boff = lds_byte(wc * 32 + fr, fq * 8);
#define PG8_SA(b, h) (((b) * 2 + (h)) * HTB)
#define PG8_SB(b, h) ((4 + (b) * 2 + (h)) * HTB)
#define PG8_STAGE(bufoff, gbase, voff) do { _Pragma("unroll") for (int _i = 0; _i < 2; ++_i) \
        __builtin_amdgcn_global_load_lds((const unsigned*)((const char*)(gbase) + (voff)[_i]), (PG8_LAS unsigned*)(lds + (bufoff) + ldsw + _i * 8192), 16, 0, 0); } while (0)
#define PG8_LDA(dst, b, h) do { _Pragma("unroll") for (int m = 0; m < 4; ++m) _Pragma("unroll") for (int k = 0; k < 2; ++k) dst[m][k] = *(const PG8_LAS bf16x8*)(lds + PG8_SA(b, h) + aoff + m * 2048 + k * 1024); } while (0)
#define PG8_LDB(dst, b, h) do { _Pragma("unroll") for (int n = 0; n < 2; ++n) _Pragma("unroll") for (int k = 0; k < 2; ++k) dst[n][k] = *(const PG8_LAS bf16x8*)(lds + PG8_SB(b, h) + boff + n * 2048 + k * 1024); } while (0)
#define PG8_MMA(ai, bj, At, Bt) do { __builtin_amdgcn_s_setprio(1); _Pragma("unroll") for (int m = 0; m < 4; ++m) _Pragma("unroll") for (int n = 0; n < 2; ++n) _Pragma("unroll") for (int k = 0; k < 2; ++k) \
        acc[ai][bj][m][n] = __builtin_amdgcn_mfma_f32_16x16x32_bf16(Bt[n][k], At[m][k], acc[ai][bj][m][n], 0, 0, 0); __builtin_amdgcn_s_setprio(0); } while (0)
#define PG8_WAIT_V(n) asm volatile("s_waitcnt vmcnt(" #n ")" ::: "memory")
#define PG8_WAIT_L(n) asm volatile("s_waitcnt lgkmcnt(" #n ")" ::: "memory")
#define PG8_BAR __builtin_amdgcn_s_barrier()
#define PG8_SCHED __builtin_amdgcn_sched_barrier(0)
    Unit cur, nxt; int ui = 0;
    if (!S.next(0, cur)) return;
    f32x4 acc[2][2][4][2];
#pragma unroll
    for (int a = 0; a < 2; ++a)
#pragma unroll
        for (int b = 0; b < 2; ++b)
#pragma unroll
            for (int m = 0; m < 4; ++m)
#pragma unroll
                for (int n = 0; n < 2; ++n) acc[a][b][m][n] = (f32x4){0.f, 0.f, 0.f, 0.f};
    bf16x8 At[4][2], B0[2][2], B1[2][2];
    const char* cA = (const char*)g.A + (size_t)cur.pm * tstep; const char* cB = (const char*)g.Bt + (size_t)cur.pn * tstep;
    S.a_ready(cur);
    PG8_STAGE(PG8_SB(0, 0), cB, voffB); PG8_STAGE(PG8_SA(0, 0), cA, voffA); PG8_STAGE(PG8_SB(0, 1), cB + hstep, voffB); PG8_STAGE(PG8_SA(0, 1), cA + hstep, voffA);
    if (wr == 1) PG8_BAR;
    PG8_WAIT_V(4); PG8_BAR;
    PG8_STAGE(PG8_SB(1, 0), cB + kstep, voffB); PG8_STAGE(PG8_SA(1, 0), cA + kstep, voffA); PG8_STAGE(PG8_SB(1, 1), cB + hstep + kstep, voffB);
    PG8_WAIT_V(6); PG8_BAR;
    for (;;) {
        const bool has_next = S.next(ui + 1, nxt);
        const char* nA = has_next ? (const char*)g.A + (size_t)nxt.pm * tstep : cA; const char* nB = has_next ? (const char*)g.Bt + (size_t)nxt.pn * tstep : cB;
        for (int t = 0; t < nt; t += 2) {
            const bool last = (t == nt - 2);
            const char* a1 = cA + (size_t)(t + 1) * kstep;
            const char* a2 = last ? nA : cA + (size_t)(t + 2) * kstep; const char* b2 = last ? nB : cB + (size_t)(t + 2) * kstep;
            const char* a3 = a2 + kstep; const char* b3 = b2 + kstep;
            if (last && has_next) S.a_ready(nxt);
            PG8_LDB(B0, 0, 0); PG8_SCHED; PG8_LDA(At, 0, 0); PG8_STAGE(PG8_SA(1, 1), a1 + hstep, voffA);
            PG8_WAIT_L(8); PG8_BAR; PG8_WAIT_L(0); PG8_MMA(0, 0, At, B0); PG8_BAR; PG8_SCHED;
            PG8_LDB(B1, 0, 1); PG8_STAGE(PG8_SB(0, 0), b2, voffB);
            PG8_BAR; PG8_WAIT_L(0); PG8_MMA(0, 1, At, B1); PG8_BAR;
            PG8_LDA(At, 0, 1); PG8_STAGE(PG8_SA(0, 0), a2, voffA);
            PG8_BAR; PG8_WAIT_L(0); PG8_MMA(1, 0, At, B0); PG8_BAR; PG8_SCHED;
            PG8_STAGE(PG8_SB(0, 1), b2 + hstep, voffB);
            PG8_WAIT_V(6); PG8_BAR; PG8_MMA(1, 1, At, B1); PG8_BAR;
            PG8_LDB(B0, 1, 0); PG8_SCHED; PG8_LDA(At, 1, 0); PG8_STAGE(PG8_SA(0, 1), a2 + hstep, voffA);
            PG8_WAIT_L(8); PG8_BAR; PG8_WAIT_L(0); PG8_MMA(0, 0, At, B0); PG8_BAR; PG8_SCHED;
            PG8_LDB(B1, 1, 1); PG8_STAGE(PG8_SB(1, 0), b3, voffB);
            PG8_BAR; PG8_WAIT_L(0); PG8_MMA(0, 1, At, B1); PG8_BAR;
            PG8_LDA(At, 1, 1); PG8_STAGE(PG8_SA(1, 0), a3, voffA);
            PG8_BAR; PG8_WAIT_L(0); PG8_MMA(1, 0, At, B0); PG8_BAR; PG8_SCHED;
            PG8_STAGE(PG8_SB(1, 1), b3 + hstep, voffB);
            PG8_WAIT_V(6); PG8_BAR; PG8_MMA(1, 1, At, B1); PG8_BAR;
        }
        if constexpr (!Epi::AFTER_DRAIN) { E(acc, cur, wr, wc, fr, fq); S.done(cur); }
        if (!has_next) break;
#pragma unroll
        for (int a = 0; a < 2; ++a)
#pragma unroll
            for (int b = 0; b < 2; ++b)
#pragma unroll
                for (int m = 0; m < 4; ++m)
#pragma unroll
                    for (int n = 0; n < 2; ++n) acc[a][b][m][n] = (f32x4){0.f, 0.f, 0.f, 0.f};
        cur = nxt; cA = nA; cB = nB; ++ui;
    }
    PG8_WAIT_V(0);
    if (wr == 0) PG8_BAR;
    PG8_BAR;
    if constexpr (Epi::AFTER_DRAIN) { E.fused(acc, cur, wr, wc, fr, fq, lds, wid, lane); S.done(cur); }
#undef PG8_SA
#undef PG8_SB
#undef PG8_STAGE
#undef PG8_LDA
#undef PG8_LDB
#undef PG8_MMA
#undef PG8_WAIT_V
#undef PG8_WAIT_L
#undef PG8_BAR
#undef PG8_SCHED
}
}
#define LAS __attribute__((address_space(3)))
#define GAS __attribute__((address_space(1)))
typedef unsigned short bf16_t;
typedef short bf16x8 __attribute__((ext_vector_type(8)));
typedef float f32x4 __attribute__((ext_vector_type(4)));
typedef float f32x2 __attribute__((ext_vector_type(2)));
typedef float f32x16 __attribute__((ext_vector_type(16)));
typedef unsigned u32x4 __attribute__((ext_vector_type(4)));
typedef unsigned u32x2 __attribute__((ext_vector_type(2)));
typedef LAS unsigned char* lptr;

constexpr int D = 1024, NB = 16, SEQ = 4096, CTX = 256, DEPTH = 4;
constexpr int GB = 8, NGRP = 2;
constexpr int RC = GB * CTX;
constexpr int RL = GB * SEQ;
constexpr int MG = RC + RL;
constexpr int RCX = GB * 320;
constexpr int MGX = RCX + RL;
constexpr int INW = 9216, DFF = 2816, NUP = 2 * DFF;
constexpr int O_RGX = 0, O_RGG = 1024, O_HG = 2048, O_GA = 7168, O_GB = 8192;
constexpr float EPS = 1e-6f;
constexpr int NTHREADS = 512;
constexpr int LDS_BYTES = 147456;
constexpr int XB_LDS_OFF = 147456 - 64;

constexpr size_t MiB = 1u << 20;
constexpr size_t WS_MOD = 1 * MiB;
constexpr size_t WS_LB = 2 * MiB + 768 * 1024;
constexpr size_t WS_XC = 3 * MiB;
constexpr size_t WS_WIN = 19 * MiB;
constexpr size_t WS_WPRG = 37 * MiB, WS_WPHG = 39 * MiB, WS_WOUT = 41 * MiB;
constexpr size_t WS_WUP = 43 * MiB;
constexpr size_t WS_WDN = 54 * MiB;
constexpr size_t WS_H = 60 * MiB;
constexpr size_t WS_R0 = 129 * MiB;
constexpr size_t WS_OF = 197 * MiB;
constexpr size_t WS_OB = 265 * MiB;
constexpr size_t WS_Z = 333 * MiB;
constexpr size_t WS_END = 945 * MiB;

__device__ __forceinline__ unsigned f2bf(float f) { unsigned u = __float_as_uint(f); return (u + 0x7fffu + ((u >> 16) & 1u)) >> 16; }
__device__ __forceinline__ unsigned pk2(float lo, float hi) { unsigned r; asm("v_cvt_pk_bf16_f32 %0, %1, %2" : "=v"(r) : "v"(lo), "v"(hi)); return r; }
__device__ __forceinline__ float bflo(unsigned w) { return __uint_as_float(w << 16); }
__device__ __forceinline__ float bfhi(unsigned w) { return __uint_as_float(w & 0xffff0000u); }
__device__ __forceinline__ float bf1(unsigned short s) { return __uint_as_float(((unsigned)s) << 16); }
__device__ __forceinline__ float sigm(float x) { return __builtin_amdgcn_rcpf(1.0f + __builtin_amdgcn_exp2f(-1.4426950408889634f * x)); }
__device__ __forceinline__ float wave_sum(float v) {
#pragma unroll
    for (int o = 1; o < 64; o <<= 1) v += __shfl_xor(v, o);
    return v;
}
#define LBAR() do { asm volatile("s_waitcnt lgkmcnt(0)" ::: "memory"); __builtin_amdgcn_s_barrier(); asm volatile("" ::: "memory"); } while (0)
#define MFMA32(a, b, c) __builtin_amdgcn_mfma_f32_32x32x16_bf16((a), (b), (c), 0, 0, 0)
__device__ __forceinline__ int crow(int reg, int h) { return (reg & 3) + 8 * (reg >> 2) + 4 * h; }

struct EpiStore {
    static constexpr bool PERM = true, AFTER_DRAIN = false;
    GAS bf16_t* O; int ldc; int row_off;
    __device__ __forceinline__ void operator()(const f32x4 (&acc)[2][2][4][2], const pg8::Unit& u, int wr, int wc, int fr, int fq) const {
        const int row0 = row_off + u.pm * 256 + wr * 64 + fr, col0 = u.pn * 256 + wc * 32 + 8 * fq;
#pragma unroll
        for (int ai = 0; ai < 2; ++ai)
#pragma unroll
            for (int m = 0; m < 4; ++m) { GAS bf16_t* rowp = O + (size_t)(row0 + ai * 128 + m * 16) * ldc + col0;
#pragma unroll
                for (int bj = 0; bj < 2; ++bj) { const f32x4 v0 = acc[ai][bj][m][0], v1 = acc[ai][bj][m][1];
                    u32x4 w; w.x = pg8::cvt_pk_bf16(v0[0], v0[1]); w.y = pg8::cvt_pk_bf16(v0[2], v0[3]); w.z = pg8::cvt_pk_bf16(v1[0], v1[1]); w.w = pg8::cvt_pk_bf16(v1[2], v1[3]);
                    *(GAS u32x4*)(rowp + bj * 128) = w; } }
    }
};
struct EpiZ {
    static constexpr bool PERM = true, AFTER_DRAIN = false;
    GAS bf16_t* O; const GAS float* lb;
    __device__ __forceinline__ void operator()(const f32x4 (&acc)[2][2][4][2], const pg8::Unit& u, int wr, int wc, int fr, int fq) const {
        const int row0 = u.pm * 256 + wr * 64 + fr, col0 = u.pn * 256 + wc * 32 + 8 * fq;
        const int ct = u.pn * 256;
        const int mode = (ct >= O_HG && ct < O_HG + 1024) ? 1 : ((ct >= O_HG + 1024 && ct < O_HG + 3072) ? 2 : 0);
        float lbv[2][8];
        if (mode == 2) {
#pragma unroll
            for (int bj = 0; bj < 2; ++bj) { const GAS float* lp = lb + ((col0 + bj * 128) & 1023); const f32x4 a = *(const GAS f32x4*)lp, b = *(const GAS f32x4*)(lp + 4);
#pragma unroll
                for (int j = 0; j < 4; ++j) { lbv[bj][j] = a[j]; lbv[bj][4 + j] = b[j]; } }
        }
#pragma unroll
        for (int ai = 0; ai < 2; ++ai)
#pragma unroll
            for (int m = 0; m < 4; ++m) { GAS bf16_t* rowp = O + (size_t)(row0 + ai * 128 + m * 16) * INW + col0;
#pragma unroll
                for (int bj = 0; bj < 2; ++bj) { const f32x4 v0 = acc[ai][bj][m][0], v1 = acc[ai][bj][m][1];
                    float o[8] = {v0[0], v0[1], v0[2], v0[3], v1[0], v1[1], v1[2], v1[3]};
                    u32x4 w;
                    if (mode == 2) { unsigned hb[8];
#pragma unroll
                        for (int j = 0; j < 8; ++j) { const float z = fminf(fmaxf(o[j], -30.f), 30.f); const float lbj = lbv[bj][j]; const float lf = __builtin_amdgcn_logf(lbj + (1.0f - lbj) * sigm(z));
                            hb[j] = (unsigned)__builtin_bit_cast(unsigned short, (_Float16)lf); }
                        w.x = hb[0] | (hb[1] << 16); w.y = hb[2] | (hb[3] << 16); w.z = hb[4] | (hb[5] << 16); w.w = hb[6] | (hb[7] << 16);
                    } else {
                        if (mode == 1) {
#pragma unroll
                            for (int j = 0; j < 8; ++j) o[j] = o[j] * sigm(o[j]); }
                        w.x = pg8::cvt_pk_bf16(o[0], o[1]); w.y = pg8::cvt_pk_bf16(o[2], o[3]); w.z = pg8::cvt_pk_bf16(o[4], o[5]); w.w = pg8::cvt_pk_bf16(o[6], o[7]);
                    }
                    *(GAS u32x4*)(rowp + bj * 128) = w; } }
    }
};
template <int MODE> struct EpiGate {
    static constexpr bool PERM = true, AFTER_DRAIN = false;
    const GAS bf16_t* Zg; const GAS bf16_t* T; GAS bf16_t* O; int row_off;
    __device__ __forceinline__ void operator()(const f32x4 (&acc)[2][2][4][2], const pg8::Unit& u, int wr, int wc, int fr, int fq) const {
        const int row0 = row_off + u.pm * 256 + wr * 64 + fr, col0 = u.pn * 256 + wc * 32 + 8 * fq;
#pragma unroll
        for (int ai = 0; ai < 2; ++ai) {
            u32x4 gw[4][2], tw[4][2];
#pragma unroll
            for (int m = 0; m < 4; ++m)
#pragma unroll
                for (int bj = 0; bj < 2; ++bj) { const size_t row = (size_t)(row0 + ai * 128 + m * 16); const int col = col0 + bj * 128;
                    gw[m][bj] = *(const GAS u32x4*)(Zg + row * INW + col); if (MODE == 1) tw[m][bj] = *(const GAS u32x4*)(T + row * D + col); }
#pragma unroll
            for (int m = 0; m < 4; ++m)
#pragma unroll
                for (int bj = 0; bj < 2; ++bj) { const size_t row = (size_t)(row0 + ai * 128 + m * 16); const int col = col0 + bj * 128;
                    const u32x4 g4 = gw[m][bj];
                    const f32x4 v0 = acc[ai][bj][m][0], v1 = acc[ai][bj][m][1];
                    float o[8];
                    o[0] = sigm(bflo(g4.x)) * v0[0]; o[1] = sigm(bfhi(g4.x)) * v0[1]; o[2] = sigm(bflo(g4.y)) * v0[2]; o[3] = sigm(bfhi(g4.y)) * v0[3];
                    o[4] = sigm(bflo(g4.z)) * v1[0]; o[5] = sigm(bfhi(g4.z)) * v1[1]; o[6] = sigm(bflo(g4.w)) * v1[2]; o[7] = sigm(bfhi(g4.w)) * v1[3];
                    if (MODE == 1) { const u32x4 t4 = tw[m][bj];
                        o[0] += bflo(t4.x); o[1] += bfhi(t4.x); o[2] += bflo(t4.y); o[3] += bfhi(t4.y); o[4] += bflo(t4.z); o[5] += bfhi(t4.z); o[6] += bflo(t4.w); o[7] += bfhi(t4.w); }
                    u32x4 w; w.x = pg8::cvt_pk_bf16(o[0], o[1]); w.y = pg8::cvt_pk_bf16(o[2], o[3]); w.z = pg8::cvt_pk_bf16(o[4], o[5]); w.w = pg8::cvt_pk_bf16(o[6], o[7]);
                    *(GAS u32x4*)(O + row * D + col) = w; }
        }
    }
};
struct EpiUp {
    static constexpr bool PERM = true, AFTER_DRAIN = false;
    GAS bf16_t* ACT; const GAS float* cw; const GAS float* cb; int pm_off;
    __device__ __forceinline__ void operator()(const f32x4 (&acc)[2][2][4][2], const pg8::Unit& u, int wr, int wc, int fr, int fq) const {
        const int lane = tid_opaque() & 63;
        const int ch0 = u.pn * 128 + wc * 32 + 8 * fq;
        const int pmv = u.pm + pm_off;
        const int lup = (lane & 48) | ((lane + 1) & 15), ldn = (lane & 48) | ((lane - 1) & 15);
        f32x4 cw0[2], cw1[2], cw2[2], cbb[2];
#pragma unroll
        for (int n = 0; n < 2; ++n) { const int chn = ch0 + 4 * n; cw0[n] = *(const GAS f32x4*)(cw + chn); cw1[n] = *(const GAS f32x4*)(cw + DFF + chn); cw2[n] = *(const GAS f32x4*)(cw + 2 * DFF + chn); cbb[n] = *(const GAS f32x4*)(cb + chn); }
#pragma unroll
        for (int ai = 0; ai < 2; ++ai) {
            long drow[4]; bool ok[4];
#pragma unroll
            for (int m = 0; m < 4; ++m) {
                const int r64 = 16 * m + fr; ok[m] = true;
                if (pmv < 10) { const int G = pmv * 4 + ai * 2 + wr, bl = G / 5, gi = G - bl * 5, tok = 62 * gi - 1 + r64; ok[m] = (r64 >= 1) && (r64 <= 62) && (tok < CTX); drow[m] = (long)bl * CTX + tok; }
                else drow[m] = (long)RC + (long)(pmv - 10) * 256 + ai * 128 + wr * 64 + r64;
            }
            unsigned pw[4][4];
#pragma unroll
            for (int n = 0; n < 2; ++n) {
                const f32x4 w0 = cw0[n], w1 = cw1[n], w2 = cw2[n], bb = cbb[n];
#pragma unroll
                for (int jp = 0; jp < 2; ++jp) {
                    float res[2][4];
#pragma unroll
                    for (int jj = 0; jj < 2; ++jj) { const int j = 2 * jp + jj;
                        float ru[4], rd[4];
#pragma unroll
                        for (int m = 0; m < 4; ++m) { const int gi = __float_as_int(acc[ai][0][m][n][j]);
                            ru[m] = __int_as_float(__builtin_amdgcn_update_dpp(0, gi, 0x12F, 0xf, 0xf, false)); rd[m] = __int_as_float(__builtin_amdgcn_update_dpp(0, gi, 0x121, 0xf, 0xf, false)); }
#pragma unroll
                        for (int m = 0; m < 4; ++m) {
                            const float up = (fr < 15) ? ru[m] : (m < 3 ? ru[m < 3 ? m + 1 : 3] : 0.f);
                            const float dn = (fr > 0) ? rd[m] : (m > 0 ? rd[m > 0 ? m - 1 : 0] : 0.f);
                            const float cv = bb[j] + w0[j] * dn + w1[j] * acc[ai][0][m][n][j] + w2[j] * up;
                            res[jj][m] = cv * sigm(cv) * acc[ai][1][m][n][j];
                        } }
#pragma unroll
                    for (int m = 0; m < 4; ++m) pw[m][2 * n + jp] = pg8::cvt_pk_bf16(res[0][m], res[1][m]);
                }
            }
#pragma unroll
            for (int m = 0; m < 4; ++m) if (ok[m]) { u32x4 w; w.x = pw[m][0]; w.y = pw[m][1]; w.z = pw[m][2]; w.w = pw[m][3]; *(GAS u32x4*)(ACT + (size_t)drow[m] * DFF + ch0) = w; }
        }
    }
};

template <bool UPMAP>
__device__ __forceinline__ void conv_item(const GAS float* W, int K, int N, GAS bf16_t* WT, LAS float* scr, int item, int lane) {
    const int nblk = N / 32, kb = item / nblk, nb = item % nblk, k0 = 64 * kb, n0 = 32 * nb;
    float wv[32];
#pragma unroll
    for (int i = 0; i < 32; ++i) { const int kk = 2 * i + (lane >> 5); wv[i] = __builtin_nontemporal_load(W + (size_t)(k0 + kk) * N + n0 + (lane & 31)); }
#pragma unroll
    for (int i = 0; i < 32; ++i) { const int kk = 2 * i + (lane >> 5); scr[kk * 33 + (lane & 31)] = wv[i]; }
    asm volatile("s_waitcnt lgkmcnt(0)" ::: "memory");
    int d0 = n0;
    if (UPMAP) { if (n0 < DFF) d0 = (n0 >> 7) * 256 + (n0 & 127); else { const int n2 = n0 - DFF; d0 = (n2 >> 7) * 256 + 128 + (n2 & 127); } }
    const int c = lane & 7;
#pragma unroll
    for (int j = 0; j < 4; ++j) { const int n = (lane >> 3) + 8 * j; const LAS float* s = scr + (8 * c) * 33 + n;
        u32x4 o; o.x = pk2(s[0 * 33], s[1 * 33]); o.y = pk2(s[2 * 33], s[3 * 33]); o.z = pk2(s[4 * 33], s[5 * 33]); o.w = pk2(s[6 * 33], s[7 * 33]);
        *(GAS u32x4*)(WT + (size_t)(d0 + n) * K + k0 + 8 * c) = o; }
    asm volatile("s_waitcnt lgkmcnt(0)" ::: "memory");
}
struct Ptrs {
    const GAS float*x, *c, *ctx, *c_ctx, *w_ada, *b_ada, *g_pre_mix, *g_post_mix, *g_pre_ffn, *g_post_ffn, *w_in, *rg_conv_w, *rg_conv_b, *rg_wa, *rg_ba, *rg_wx, *rg_bx, *rg_lam,
        *hg_lb, *hg_out_norm, *w_proj_rg, *w_proj_hg, *w_out, *ffn_w_up, *ffn_conv_w, *ffn_conv_b, *ffn_w_down;
    GAS float* out; GAS unsigned char* ws;
};
__device__ __forceinline__ void convert_weights(const Ptrs& P, lptr lds, int l, int part = 0, int skip = 0) {
    const int lane = tid_opaque() & 63, wave = __builtin_amdgcn_readfirstlane(tid_opaque() >> 6);
    LAS float* scr = (LAS float*)(lds + wave * 8448);
    if ((int)blockIdx.x < skip) return;
    const int gw = ((int)blockIdx.x - skip) * 8 + wave, NGW = ((int)gridDim.x - skip) * 8;
    constexpr int I_IN = 16 * 288, I_P = 16 * 32, I_UP = 16 * 176, I_DN = 44 * 32, NIT = I_IN + 3 * I_P + I_UP + I_DN;
    const int it_lo = (part == 2) ? NIT - I_DN : 0, it_hi = (part == 1) ? NIT - I_DN : NIT;
    for (int it = it_lo + gw; it < it_hi; it += NGW) {
        int r = it;
        if (r < I_IN) { conv_item<false>(P.w_in + (size_t)l * D * INW, D, INW, (GAS bf16_t*)(P.ws + WS_WIN), scr, r, lane); continue; } r -= I_IN;
        if (r < I_P) { conv_item<false>(P.w_proj_rg + (size_t)l * D * D, D, D, (GAS bf16_t*)(P.ws + WS_WPRG), scr, r, lane); continue; } r -= I_P;
        if (r < I_P) { conv_item<false>(P.w_proj_hg + (size_t)l * D * D, D, D, (GAS bf16_t*)(P.ws + WS_WPHG), scr, r, lane); continue; } r -= I_P;
        if (r < I_P) { conv_item<false>(P.w_out + (size_t)l * D * D, D, D, (GAS bf16_t*)(P.ws + WS_WOUT), scr, r, lane); continue; } r -= I_P;
        if (r < I_UP) { conv_item<true>(P.ffn_w_up + (size_t)l * D * NUP, D, NUP, (GAS bf16_t*)(P.ws + WS_WUP), scr, r, lane); continue; } r -= I_UP;
        conv_item<false>(P.ffn_w_down + (size_t)l * DFF * D, DFF, D, (GAS bf16_t*)(P.ws + WS_WDN), scr, r, lane);
    }
}
__device__ __forceinline__ void mods_phase(const Ptrs& P, lptr lds) {
    const int tid = tid_opaque(), lane = tid & 63, wave = __builtin_amdgcn_readfirstlane(tid >> 6);
    LAS float* S = (LAS float*)lds;
    LAS float* RED = (LAS float*)(lds + 17 * 1024 * 4);
    GAS float* MOD = (GAS float*)(P.ws + WS_MOD);
    for (int idx = tid; idx < 17 * 1024; idx += NTHREADS) { const int r = idx >> 10, k = idx & 1023; const float v = r < 16 ? P.c[r * 1024 + k] : P.c_ctx[k]; S[idx] = v * sigm(v); }
    if (blockIdx.x == 0) { GAS float* LB = (GAS float*)(P.ws + WS_LB);
        for (int c = tid; c < 1024; c += NTHREADS) { const float p0 = P.hg_lb[c], p1 = P.hg_lb[1024 + c], p2 = P.hg_lb[2048 + c], p3 = P.hg_lb[3072 + c];
            const float mx = fmaxf(fmaxf(p0, p1), fmaxf(p2, p3)); const float e0 = expf(p0 - mx), e1 = expf(p1 - mx), e2 = expf(p2 - mx), e3 = expf(p3 - mx); const float inv = 1.0f / (e0 + e1 + e2 + e3);
            LB[c] = 0.f; LB[1024 + c] = e1 * inv; LB[2048 + c] = (e1 + e2) * inv; LB[3072 + c] = (e1 + e2 + e3) * inv; } }
    __syncthreads();
    for (int task = blockIdx.x; task < 4 * 96; task += gridDim.x) {
        const int l = task / 96, n0 = (task % 96) * 64;
        float acc[17];
#pragma unroll
        for (int r = 0; r < 17; ++r) acc[r] = 0.f;
        const GAS float* wp = P.w_ada + ((size_t)l * 1024 + wave * 128) * 6144 + n0 + lane;
#pragma unroll 4
        for (int kk = 0; kk < 128; ++kk) { const float w = __builtin_nontemporal_load(wp + (size_t)kk * 6144);
#pragma unroll
            for (int r = 0; r < 17; ++r) acc[r] += S[r * 1024 + wave * 128 + kk] * w; }
#pragma unroll
        for (int r = 0; r < 17; ++r) RED[(wave * 17 + r) * 64 + lane] = acc[r];
        __syncthreads();
        for (int idx = tid; idx < 17 * 64; idx += NTHREADS) { const int r = idx >> 6, ln = idx & 63; float s = P.b_ada[l * 6144 + n0 + ln];
#pragma unroll
            for (int w = 0; w < 8; ++w) s += RED[(w * 17 + r) * 64 + ln];
            MOD[(size_t)(l * 17 + r) * 6144 + n0 + ln] = s; }
        __syncthreads();
    }
}
__device__ __forceinline__ const GAS float* modp(const Ptrs& P, int l, int r, int j) { return (const GAS float*)(P.ws + WS_MOD) + ((size_t)(l * 17 + r) * 6 + j) * 1024; }

__device__ __forceinline__ void row_op(const GAS float* xsrc, GAS float* xdst, const GAS bf16_t* y, const GAS float* gate, const GAS float* gpost,
                                       const GAS float* gpre, const GAS float* mscale, const GAS float* mshift, GAS bf16_t* h0, GAS bf16_t* h1, int lane) {
    f32x4 v[4];
#pragma unroll
    for (int j = 0; j < 4; ++j) v[j] = *((const GAS f32x4*)xsrc + lane + 64 * j);
    if (y) {
        f32x4 yy[4]; float ss = 0.f;
#pragma unroll
        for (int j = 0; j < 4; ++j) { const u32x2 w = *((const GAS u32x2*)y + lane + 64 * j); yy[j] = (f32x4){bflo(w.x), bfhi(w.x), bflo(w.y), bfhi(w.y)};
            ss += (yy[j][0] * yy[j][0] + yy[j][1] * yy[j][1]) + (yy[j][2] * yy[j][2] + yy[j][3] * yy[j][3]); }
        const float r = __builtin_amdgcn_rsqf(wave_sum(ss) * (1.0f / 1024.0f) + EPS);
#pragma unroll
        for (int j = 0; j < 4; ++j) { const f32x4 gt = *((const GAS f32x4*)gate + lane + 64 * j), gp = *((const GAS f32x4*)gpost + lane + 64 * j); v[j] = v[j] + gt * (yy[j] * r * gp); }
        if (xdst) {
#pragma unroll
            for (int j = 0; j < 4; ++j) *((GAS f32x4*)xdst + lane + 64 * j) = v[j]; }
    }
    if (h0) {
        float s2 = 0.f;
#pragma unroll
        for (int j = 0; j < 4; ++j) s2 += (v[j][0] * v[j][0] + v[j][1] * v[j][1]) + (v[j][2] * v[j][2] + v[j][3] * v[j][3]);
        const float r2 = __builtin_amdgcn_rsqf(wave_sum(s2) * (1.0f / 1024.0f) + EPS);
#pragma unroll
        for (int j = 0; j < 4; ++j) { const f32x4 gp = *((const GAS f32x4*)gpre + lane + 64 * j), sc = *((const GAS f32x4*)mscale + lane + 64 * j), sh = *((const GAS f32x4*)mshift + lane + 64 * j);
            const f32x4 hv = (v[j] * r2 * gp) * (sc + 1.0f) + sh;
            u32x2 w; w.x = pk2(hv[0], hv[1]); w.y = pk2(hv[2], hv[3]);
            *((GAS u32x2*)h0 + lane + 64 * j) = w; if (h1) *((GAS u32x2*)h1 + lane + 64 * j) = w; }
    }
}
template <int NR, bool HASY, bool HASH>
__device__ __forceinline__ void row_block(const GAS float* xsrc, GAS float* xdst, const GAS bf16_t* y, GAS bf16_t* h, const f32x4 (&A1)[4], const f32x4 (&A2)[4], const f32x4 (&A3)[4], int lane) {
    f32x4 v[NR][4]; f32x4 yy[NR][4]; float ss[NR];
#pragma unroll
    for (int q = 0; q < NR; ++q)
#pragma unroll
        for (int j = 0; j < 4; ++j) v[q][j] = __builtin_nontemporal_load((const GAS f32x4*)(xsrc + (size_t)q * D) + lane + 64 * j);
    if (HASY) {
#pragma unroll
        for (int q = 0; q < NR; ++q) { ss[q] = 0.f;
#pragma unroll
            for (int j = 0; j < 4; ++j) { const u32x2 w = __builtin_nontemporal_load((const GAS u32x2*)(y + (size_t)q * D) + lane + 64 * j); yy[q][j] = (f32x4){bflo(w.x), bfhi(w.x), bflo(w.y), bfhi(w.y)};
                ss[q] += (yy[q][j][0] * yy[q][j][0] + yy[q][j][1] * yy[q][j][1]) + (yy[q][j][2] * yy[q][j][2] + yy[q][j][3] * yy[q][j][3]); } }
#pragma unroll
        for (int o = 1; o < 64; o <<= 1) {
#pragma unroll
            for (int q = 0; q < NR; ++q) ss[q] += __shfl_xor(ss[q], o); }
#pragma unroll
        for (int q = 0; q < NR; ++q) { const float r = __builtin_amdgcn_rsqf(ss[q] * (1.0f / 1024.0f) + EPS);
#pragma unroll
            for (int j = 0; j < 4; ++j) { v[q][j] = v[q][j] + A1[j] * (yy[q][j] * r); __builtin_nontemporal_store(v[q][j], (GAS f32x4*)(xdst + (size_t)q * D) + lane + 64 * j); } }
    }
    if (HASH) {
        float s2[NR];
#pragma unroll
        for (int q = 0; q < NR; ++q) { s2[q] = 0.f;
#pragma unroll
            for (int j = 0; j < 4; ++j) s2[q] += (v[q][j][0] * v[q][j][0] + v[q][j][1] * v[q][j][1]) + (v[q][j][2] * v[q][j][2] + v[q][j][3] * v[q][j][3]); }
#pragma unroll
        for (int o = 1; o < 64; o <<= 1) {
#pragma unroll
            for (int q = 0; q < NR; ++q) s2[q] += __shfl_xor(s2[q], o); }
#pragma unroll
        for (int q = 0; q < NR; ++q) { const float r2 = __builtin_amdgcn_rsqf(s2[q] * (1.0f / 1024.0f) + EPS);
#pragma unroll
            for (int j = 0; j < 4; ++j) { const f32x4 hv = (v[q][j] * r2) * A2[j] + A3[j]; u32x2 w; w.x = pg8::cvt_pk_bf16(hv[0], hv[1]); w.y = pg8::cvt_pk_bf16(hv[2], hv[3]); *((GAS u32x2*)(h + (size_t)q * D) + lane + 64 * j) = w; } }
    }
}
__device__ __forceinline__ void rowop_phase(const Ptrs& P, int kind, int g, int l) {
    const int lane = tid_opaque() & 63, wave = __builtin_amdgcn_readfirstlane(tid_opaque() >> 6);
    const int gw = blockIdx.x * 8 + wave, NGW = gridDim.x * 8;
    GAS bf16_t* H = (GAS bf16_t*)(P.ws + WS_H); const GAS bf16_t* Y = (const GAS bf16_t*)(P.ws + WS_OF); GAS float* XC = (GAS float*)(P.ws + WS_XC);
    for (int blk = gw; blk < RL / 16; blk += NGW) {
        const int rl = blk * 16, b = g * GB + (rl >> 12); const size_t xrow = (size_t)(b * SEQ + (rl & 4095)) * D; const int r = RC + rl;
        const GAS float*pg = nullptr, *pp = nullptr, *pq, *psc, *psh;
        if (kind == 0) { pq = P.g_pre_mix + l * D; psc = modp(P, l, b, 1); psh = modp(P, l, b, 0); }
        else if (kind == 1) { pg = modp(P, l, b, 2); pp = P.g_post_mix + l * D; pq = P.g_pre_ffn + l * D; psc = modp(P, l, b, 4); psh = modp(P, l, b, 3); }
        else { const int ln = l < 3 ? l + 1 : l; pg = modp(P, l, b, 5); pp = P.g_post_ffn + l * D; pq = P.g_pre_mix + ln * D; psc = modp(P, ln, b, 1); psh = modp(P, ln, b, 0); }
        f32x4 A1[4], A2[4], A3[4];
#pragma unroll
        for (int j = 0; j < 4; ++j) { A1[j] = (kind == 0) ? (f32x4){0.f, 0.f, 0.f, 0.f} : *((const GAS f32x4*)pg + lane + 64 * j) * *((const GAS f32x4*)pp + lane + 64 * j);
            A2[j] = *((const GAS f32x4*)pq + lane + 64 * j) * (*((const GAS f32x4*)psc + lane + 64 * j) + 1.0f); A3[j] = *((const GAS f32x4*)psh + lane + 64 * j); }
        if (kind == 0) { for (int i = 0; i < 16; i += 2) row_block<2, false, true>(P.x + xrow + (size_t)i * D, nullptr, nullptr, H + (size_t)(r + i) * D, A1, A2, A3, lane); }
        else if (kind == 1) { const GAS float* xs = (l == 0 ? P.x : P.out) + xrow; for (int i = 0; i < 16; i += 2) row_block<2, true, true>(xs + (size_t)i * D, P.out + xrow + (size_t)i * D, Y + (size_t)(r + i) * D, H + (size_t)(RCX + rl + i) * D, A1, A2, A3, lane); }
        else if (l < 3) { for (int i = 0; i < 16; i += 2) row_block<2, true, true>(P.out + xrow + (size_t)i * D, P.out + xrow + (size_t)i * D, Y + (size_t)(r + i) * D, H + (size_t)(r + i) * D, A1, A2, A3, lane); }
        else { for (int i = 0; i < 16; i += 2) row_block<2, true, false>(P.out + xrow + (size_t)i * D, P.out + xrow + (size_t)i * D, Y + (size_t)(r + i) * D, nullptr, A1, A2, A3, lane); }
    }
    if (kind != 0 && l == 3) return;
    for (int r = gw; r < RC; r += NGW) {
        const int bl = r >> 8, tc = r & 255, b = g * GB + bl, mr = 16; const size_t xrow = (size_t)(b * CTX + tc) * D;
        if (kind == 0) {
            row_op(P.ctx + xrow, nullptr, nullptr, nullptr, nullptr, P.g_pre_mix + l * D, modp(P, l, mr, 1), modp(P, l, mr, 0), H + (size_t)r * D, nullptr, lane);
        } else if (kind == 1) {
            const GAS float* xs = (l == 0 ? P.ctx : XC) + xrow; GAS float* xd = XC + xrow;
            GAS bf16_t*h0, *h1 = nullptr;
            const int gi = tc / 62, rr = tc - gi * 62 + 1; GAS bf16_t* hb = H + (size_t)(bl * 320) * D;
            h0 = hb + (size_t)(gi * 64 + rr) * D;
            if (rr == 62 && gi < 4) h1 = hb + (size_t)((gi + 1) * 64) * D;
            else if (rr == 1 && gi > 0) h1 = hb + (size_t)((gi - 1) * 64 + 63) * D;
            if (tc == 0) { u32x2 zz; zz.x = 0u; zz.y = 0u;
#pragma unroll
                for (int j = 0; j < 4; ++j) *((GAS u32x2*)hb + lane + 64 * j) = zz; }
            if (tc == 255) { u32x2 zz; zz.x = 0u; zz.y = 0u;
                for (int q = 9; q < 64; ++q) {
#pragma unroll
                    for (int j = 0; j < 4; ++j) *((GAS u32x2*)(hb + (size_t)(4 * 64 + q) * D) + lane + 64 * j) = zz; } }
            row_op(xs, xd, Y + (size_t)r * D, modp(P, l, mr, 2), P.g_post_mix + l * D, P.g_pre_ffn + l * D, modp(P, l, mr, 4), modp(P, l, mr, 3), h0, h1, lane);
        } else {
            GAS float* xd = XC + xrow;
            const bool nh = l < 3; const int ln = nh ? l + 1 : l;
            row_op(xd, xd, Y + (size_t)r * D, modp(P, l, mr, 5), P.g_post_ffn + l * D, P.g_pre_mix + ln * D, modp(P, ln, mr, 1), modp(P, ln, mr, 0), nh ? H + (size_t)r * D : nullptr, nullptr, lane);
        }
    }
}
__device__ __forceinline__ void hgout_phase(const Ptrs& P, int l, int skip) {
    const int lane = tid_opaque() & 63, wave = __builtin_amdgcn_readfirstlane(tid_opaque() >> 6);
    if ((int)blockIdx.x < skip) return;
    const int gw = ((int)blockIdx.x - skip) * 8 + wave, NGW = ((int)gridDim.x - skip) * 8;
    GAS bf16_t* OF = (GAS bf16_t*)(P.ws + WS_OF); const GAS bf16_t* OB = (const GAS bf16_t*)(P.ws + WS_OB); const GAS bf16_t* Z = (const GAS bf16_t*)(P.ws + WS_Z);
    const GAS float* gain = P.hg_out_norm + l * D + 16 * lane;
    float gn[16];
#pragma unroll
    for (int q = 0; q < 4; ++q) { const f32x4 t = *((const GAS f32x4*)gain + q); gn[4 * q] = t[0]; gn[4 * q + 1] = t[1]; gn[4 * q + 2] = t[2]; gn[4 * q + 3] = t[3]; }
    for (int r = (l == 3 ? RC : 0) + gw; r < MG; r += NGW) {
        const GAS u32x4* pf = (const GAS u32x4*)(OF + (size_t)r * D + 16 * lane); const GAS u32x4* pb = (const GAS u32x4*)(OB + (size_t)r * D + 16 * lane);
        const GAS u32x4* pg = (const GAS u32x4*)(Z + (size_t)r * INW + O_HG + 4 * 1024 + 16 * lane);
        float o[16], gv[16]; float ss = 0.f;
#pragma unroll
        for (int q = 0; q < 2; ++q) { const u32x4 a = pf[q], b = pb[q], c = pg[q];
            const unsigned aw[4] = {a.x, a.y, a.z, a.w}, bw[4] = {b.x, b.y, b.z, b.w}, cw4[4] = {c.x, c.y, c.z, c.w};
#pragma unroll
            for (int e = 0; e < 4; ++e) { const int i = 8 * q + 2 * e; o[i] = bflo(aw[e]) + bflo(bw[e]); o[i + 1] = bfhi(aw[e]) + bfhi(bw[e]); gv[i] = bflo(cw4[e]); gv[i + 1] = bfhi(cw4[e]); ss += o[i] * o[i] + o[i + 1] * o[i + 1]; } }
        ss += __shfl_xor(ss, 1); ss += __shfl_xor(ss, 2); ss += __shfl_xor(ss, 4);
        const float rr = __builtin_amdgcn_rsqf(ss * (1.0f / 128.0f) + EPS);
        u32x4 w[2];
#pragma unroll
        for (int q = 0; q < 2; ++q) { unsigned pw[4];
#pragma unroll
            for (int e = 0; e < 4; ++e) { const int i = 8 * q + 2 * e; const float y0 = o[i] * rr * gn[i] * (gv[i] * sigm(gv[i])), y1 = o[i + 1] * rr * gn[i + 1] * (gv[i + 1] * sigm(gv[i + 1])); pw[e] = pk2(y0, y1); }
            w[q].x = pw[0]; w[q].y = pw[1]; w[q].z = pw[2]; w[q].w = pw[3]; }
        GAS u32x4* po = (GAS u32x4*)(OF + (size_t)r * D + 16 * lane); po[0] = w[0]; po[1] = w[1];
    }
}
constexpr int HB_QI = 0, HB_KD = 8704, HB_KT = 17408, HB_VT = 27648, HB_E = 32768, HB_SZ = 33280;
constexpr int H_ST = 2 * HB_SZ, H_AM = H_ST + 64 * 272, H_TOT = H_AM + 32 * 80, H_END = H_TOT + 4096;
static_assert(H_END <= 131072, "hg lds");
__device__ __forceinline__ void hg_unit(const Ptrs& P, lptr lds, int l, int u) {
    const int tid = tid_opaque(), lane = tid & 63, wave = __builtin_amdgcn_readfirstlane(tid >> 6), l31 = lane & 31, hh = lane >> 5;
    const int bl = u >> 5, head = (u >> 2) & 7, dir = (u >> 1) & 1, vh = u & 1;
    const GAS bf16_t* Z = (const GAS bf16_t*)(P.ws + WS_Z);
    GAS bf16_t* O = (GAS bf16_t*)(P.ws + (dir ? WS_OB : WS_OF));
    const int kp = tid & 63, tg = tid >> 6;
    const GAS bf16_t* zq = Z + O_HG + head * 128 + 2 * kp;
    const GAS bf16_t* zf = Z + O_HG + (1 + dir) * 1024 + head * 128 + 2 * kp;
    const GAS bf16_t* zv = Z + O_HG + 3 * 1024 + head * 128 + vh * 64 + kp;
    GAS bf16_t* obase = O + head * 128 + vh * 64 + l31;
    for (int i = tid; i < 64 * 272 / 4; i += NTHREADS) *(LAS unsigned*)(lds + H_ST + 4 * i) = 0u;
    f32x16 Sacc;
#pragma unroll
    for (int i = 0; i < 16; ++i) Sacc[i] = 0.f;
    unsigned rq[4], rf[4]; unsigned short rv[4], cv[4];
    f32x2 bc[4], qv[4], kk[4];
#define HG_ROWS(j, rb, rs) long rb, rs; { const int _j = (j); if (_j < 8) { rs = dir ? -1 : 1; rb = (long)bl * CTX + (dir ? 255 - 32 * _j : 32 * _j); } \
        else { const int _m = _j - 8; const int _q0 = dir ? 4095 - 32 * _m : 32 * _m; rs = dir ? -64 : 64; rb = (long)RC + (long)bl * SEQ + (_q0 & 63) * 64 + (_q0 >> 6); } }
#define HG_LOAD(j) do { HG_ROWS(j, _rb, _rs); const long _o0 = (_rb + 4 * tg * _rs) * INW, _st = _rs * INW; \
        _Pragma("unroll") for (int i = 0; i < 4; ++i) { rq[i] = *(const GAS unsigned*)(zq + _o0 + i * _st); rf[i] = *(const GAS unsigned*)(zf + _o0 + i * _st); rv[i] = zv[_o0 + i * _st]; } } while (0)
#define HG_FEAT() do { f32x2 cum; cum.x = 0.f; cum.y = 0.f; _Pragma("unroll") for (int i = 0; i < 4; ++i) { qv[i].x = bflo(rq[i]); qv[i].y = bfhi(rq[i]); \
            f32x2 lf; lf.x = (float)__builtin_bit_cast(_Float16, (unsigned short)(rf[i] & 0xffffu)); lf.y = (float)__builtin_bit_cast(_Float16, (unsigned short)(rf[i] >> 16)); \
            f32x2 ef; ef.x = __builtin_amdgcn_exp2f(lf.x); ef.y = __builtin_amdgcn_exp2f(lf.y); kk[i] = 1.0f - ef; cum = cum + lf; bc[i] = cum; cv[i] = rv[i]; } \
        *(LAS f32x2*)(lds + H_TOT + (tg * 128 + 2 * kp) * 4) = cum; } while (0)
#define HG_WRITE(pb) do { \
        f32x2 off, blt; off.x = 0.f; off.y = 0.f; blt.x = 0.f; blt.y = 0.f; \
        _Pragma("unroll") for (int g2 = 0; g2 < 8; ++g2) { const f32x2 t = *(LAS f32x2*)(lds + H_TOT + (g2 * 128 + 2 * kp) * 4); if (g2 < tg) off = off + t; blt = blt + t; } \
        f32x2 kd[4]; \
        _Pragma("unroll") for (int i = 0; i < 4; ++i) { const int t = 4 * tg + i; const f32x2 b = bc[i] + off; \
            f32x2 e1, e2; e1.x = __builtin_amdgcn_exp2f(b.x); e1.y = __builtin_amdgcn_exp2f(b.y); e2.x = __builtin_amdgcn_exp2f(fminf(-b.x, 100.f)); e2.y = __builtin_amdgcn_exp2f(fminf(-b.y, 100.f)); \
            const f32x2 qi = qv[i] * e1; kd[i] = kk[i] * e2; \
            *(LAS unsigned*)(lds + (pb) + HB_QI + t * 272 + kp * 4) = pg8::cvt_pk_bf16(qi.x, qi.y); \
            *(LAS unsigned*)(lds + (pb) + HB_KD + t * 272 + kp * 4) = pg8::cvt_pk_bf16(kd[i].x, kd[i].y); } \
        { u32x2 w; w.x = pg8::cvt_pk_bf16(kd[0].x, kd[1].x); w.y = pg8::cvt_pk_bf16(kd[2].x, kd[3].x); *(LAS u32x2*)(lds + (pb) + HB_KT + (2 * kp) * 80 + tg * 8) = w; \
          w.x = pg8::cvt_pk_bf16(kd[0].y, kd[1].y); w.y = pg8::cvt_pk_bf16(kd[2].y, kd[3].y); *(LAS u32x2*)(lds + (pb) + HB_KT + (2 * kp + 1) * 80 + tg * 8) = w; } \
        if (tg == 0) { f32x2 e2; e2.x = __builtin_amdgcn_exp2f(blt.x); e2.y = __builtin_amdgcn_exp2f(blt.y); *(LAS f32x2*)(lds + (pb) + HB_E + (2 * kp) * 4) = e2; } \
        { u32x2 w; w.x = (unsigned)cv[0] | ((unsigned)cv[1] << 16); w.y = (unsigned)cv[2] | ((unsigned)cv[3] << 16); *(LAS u32x2*)(lds + (pb) + HB_VT + kp * 80 + tg * 8) = w; } } while (0)
    HG_LOAD(0); HG_FEAT(); HG_LOAD(1);
    LBAR();
    HG_WRITE(0);
    LBAR();
    for (int j = 0; j < 136; ++j) {
        const int pb = (j & 1) * HB_SZ;
        f32x16 o0, o1;
#pragma unroll
        for (int i = 0; i < 16; ++i) { o0[i] = 0.f; o1[i] = 0.f; }
        if (wave == 0) {
#pragma unroll
            for (int ks = 0; ks < 8; ks += 2) {
                const bf16x8 a = *(const LAS bf16x8*)(lds + pb + HB_KD + l31 * 272 + 32 * ks + 16 * hh), b = *(const LAS bf16x8*)(lds + pb + HB_QI + l31 * 272 + 32 * ks + 16 * hh);
                const bf16x8 a2 = *(const LAS bf16x8*)(lds + pb + HB_KD + l31 * 272 + 32 * (ks + 1) + 16 * hh), b2 = *(const LAS bf16x8*)(lds + pb + HB_QI + l31 * 272 + 32 * (ks + 1) + 16 * hh);
                o0 = MFMA32(a, b, o0); o1 = MFMA32(a2, b2, o1); }
        } else if (wave <= 2) {
            const int vi = wave - 1;
#pragma unroll
            for (int ks = 0; ks < 8; ks += 2) {
                const bf16x8 a = *(const LAS bf16x8*)(lds + pb + HB_QI + l31 * 272 + 32 * ks + 16 * hh), b = *(const LAS bf16x8*)(lds + H_ST + (32 * vi + l31) * 272 + 32 * ks + 16 * hh);
                const bf16x8 a2 = *(const LAS bf16x8*)(lds + pb + HB_QI + l31 * 272 + 32 * (ks + 1) + 16 * hh), b2 = *(const LAS bf16x8*)(lds + H_ST + (32 * vi + l31) * 272 + 32 * (ks + 1) + 16 * hh);
                o0 = MFMA32(a, b, o0); o1 = MFMA32(a2, b2, o1); }
        }
        { HG_FEAT(); const int jn = (j + 2 < 136) ? j + 2 : 135; HG_LOAD(jn); }
        if (wave == 0) {
#pragma unroll
            for (int gq = 0; gq < 4; ++gq) { const int s0 = 8 * gq + 4 * hh; float m[4];
#pragma unroll
                for (int e = 0; e < 4; ++e) m[e] = (s0 + e <= l31) ? (o0[4 * gq + e] + o1[4 * gq + e]) : 0.f;
                u32x2 w; w.x = pg8::cvt_pk_bf16(m[0], m[1]); w.y = pg8::cvt_pk_bf16(m[2], m[3]); *(LAS u32x2*)(lds + H_AM + l31 * 80 + s0 * 2) = w; }
        }
        LBAR();
        if (wave == 1 || wave == 2) {
            const int vi = wave - 1;
            { const bf16x8 a = *(const LAS bf16x8*)(lds + H_AM + l31 * 80 + 16 * hh), b = *(const LAS bf16x8*)(lds + pb + HB_VT + (32 * vi + l31) * 80 + 16 * hh); o0 = MFMA32(a, b, o0); }
            { const bf16x8 a = *(const LAS bf16x8*)(lds + H_AM + l31 * 80 + 32 + 16 * hh), b = *(const LAS bf16x8*)(lds + pb + HB_VT + (32 * vi + l31) * 80 + 32 + 16 * hh); o1 = MFMA32(a, b, o1); }
            HG_ROWS(j, rb, rs);
            GAS bf16_t* op = obase + 32 * vi + (rb + 4 * hh * rs) * D; const long ost = rs * D;
#pragma unroll
            for (int r = 0; r < 16; r += 2) { const int t = (r & 3) + 8 * (r >> 2); const unsigned w = pg8::cvt_pk_bf16(o0[r] + o1[r], o0[r + 1] + o1[r + 1]); op[t * ost] = (bf16_t)(w & 0xffffu); op[(t + 1) * ost] = (bf16_t)(w >> 16); }
        }
        { const int ki = wave & 3, vi2 = wave >> 2;
#pragma unroll
          for (int ks = 0; ks < 2; ++ks) { const bf16x8 a = *(const LAS bf16x8*)(lds + pb + HB_KT + (32 * ki + l31) * 80 + 32 * ks + 16 * hh), b = *(const LAS bf16x8*)(lds + pb + HB_VT + (32 * vi2 + l31) * 80 + 32 * ks + 16 * hh); Sacc = MFMA32(a, b, Sacc); }
#pragma unroll
          for (int gq = 0; gq < 4; ++gq) { const f32x4 e4 = *(const LAS f32x4*)(lds + pb + HB_E + (32 * ki + 8 * gq + 4 * hh) * 4);
#pragma unroll
              for (int e = 0; e < 4; ++e) Sacc[4 * gq + e] *= e4[e];
              u32x2 w; w.x = pg8::cvt_pk_bf16(Sacc[4 * gq], Sacc[4 * gq + 1]); w.y = pg8::cvt_pk_bf16(Sacc[4 * gq + 2], Sacc[4 * gq + 3]);
              *(LAS u32x2*)(lds + H_ST + (32 * vi2 + l31) * 272 + (32 * ki + 8 * gq + 4 * hh) * 2) = w; } }
        { const int pn = ((j + 1) & 1) * HB_SZ; HG_WRITE(pn); }
        LBAR();
    }
#undef HG_LOAD
#undef HG_FEAT
#undef HG_WRITE
#undef HG_ROWS
}

constexpr int RXB = 0, RXF = RXB + 128 * 144, RAA = RXF + 128 * 128, RBB = RAA + 128 * 128, RCAR = RBB + 128 * 128, RCARRY = RCAR + 16 * 32 * 8, REND = RCARRY + 256;
typedef float f32x4v __attribute__((ext_vector_type(4)));
#define MFMA16(a, b, c) __builtin_amdgcn_mfma_f32_16x16x32_bf16((a), (b), (c), 0, 0, 0)
__device__ __forceinline__ void rg_unit(const Ptrs& P, lptr lds, int l, int u) {
    const int tid = tid_opaque(), lane = tid & 63, wave = __builtin_amdgcn_readfirstlane(tid >> 6), l15 = lane & 15, q4 = lane >> 4;
    const int bl = u >> 5, head = (u >> 1) & 15, hf = u & 1;
    const int c0 = head * 64;
    const GAS bf16_t* Z = (const GAS bf16_t*)(P.ws + WS_Z);
    GAS bf16_t* R0 = (GAS bf16_t*)(P.ws + WS_R0);
    const int cp = tid & 31, tg = tid >> 5;
    float cwv[2][4], cbv[2];
#pragma unroll
    for (int e = 0; e < 2; ++e) { cbv[e] = P.rg_conv_b[l * 1024 + c0 + 2 * cp + e];
#pragma unroll
        for (int jj = 0; jj < 4; ++jj) cwv[e][jj] = P.rg_conv_w[(l * 4 + jj) * 1024 + c0 + 2 * cp + e]; }
    const int sc = tid & 31, sub = tid >> 5;
    const int mych = c0 + 32 * hf + sc;
    const GAS bf16_t* zx = Z + O_RGX + c0 + 2 * cp;
    const GAS bf16_t* zg = Z + O_RGG + mych;
    GAS bf16_t* rp = R0 + mych;
#pragma unroll
    for (int d = 0; d < 2; ++d) {
        bf16x8 wfa[2][2], wfx[2][2]; float c8l[2], bal[2], bxl[2];
#pragma unroll
        for (int nt = 0; nt < 2; ++nt) {
            const size_t wb = ((size_t)((l * 2 + d) * 16 + head) * 64) * 64 + 32 * hf + 16 * nt + l15;
            float fa[2][8], fx[2][8];
#pragma unroll
            for (int ks = 0; ks < 2; ++ks)
#pragma unroll
                for (int e = 0; e < 8; ++e) { const int i0 = 32 * ks + 8 * q4 + e; fa[ks][e] = P.rg_wa[wb + (size_t)i0 * 64]; fx[ks][e] = P.rg_wx[wb + (size_t)i0 * 64]; }
#pragma unroll
            for (int ks = 0; ks < 2; ++ks) { u32x4 t;
                t.x = pk2(fa[ks][0], fa[ks][1]); t.y = pk2(fa[ks][2], fa[ks][3]); t.z = pk2(fa[ks][4], fa[ks][5]); t.w = pk2(fa[ks][6], fa[ks][7]); wfa[nt][ks] = __builtin_bit_cast(bf16x8, t);
                t.x = pk2(fx[ks][0], fx[ks][1]); t.y = pk2(fx[ks][2], fx[ks][3]); t.z = pk2(fx[ks][4], fx[ks][5]); t.w = pk2(fx[ks][6], fx[ks][7]); wfx[nt][ks] = __builtin_bit_cast(bf16x8, t); }
            const int gch = (l * 2 + d) * 1024 + c0 + 32 * hf + 16 * nt + l15;
            c8l[nt] = 8.0f * 1.4426950408889634f * log1pf(expf(-P.rg_lam[gch]));
            bal[nt] = P.rg_ba[gch]; bxl[nt] = P.rg_bx[gch];
        }
#define RG_TILE(n, t0, rbase, len) int t0, len; long rbase; { const int _n = (n); if (_n < 2) { t0 = 128 * (d ? 1 - _n : _n); len = CTX; rbase = (long)bl * CTX; } else { t0 = 128 * (d ? 33 - _n : _n - 2); len = SEQ; rbase = (long)RC + (long)bl * SEQ; } }
        unsigned zr[11]; unsigned zvalid = 0u;
#define RG_LOAD(n) do { RG_TILE(n, _t0, _rb, _len); const int _ts = _t0 + 8 * tg - 1; const GAS bf16_t* _p = zx + (_rb + _ts) * INW; \
        _Pragma("unroll") for (int i = 0; i < 11; ++i) { const int _t = _ts + i; const int _tc = _t < 0 ? 0 : (_t >= _len ? _len - 1 : _t); zr[i] = *(const GAS unsigned*)(_p + (long)(_tc - _ts) * INW); } \
        zvalid = 0u; _Pragma("unroll") for (int i = 0; i < 11; ++i) { const int _t = _ts + i; if (_t >= 0 && _t < _len) zvalid |= (1u << i); } } while (0)
#define RG_CONV() do { _Pragma("unroll") for (int i = 0; i < 11; ++i) zr[i] = ((zvalid >> i) & 1u) ? zr[i] : 0u; \
        _Pragma("unroll") for (int i = 0; i < 8; ++i) { \
            const float x0 = cbv[0] + cwv[0][0] * bflo(zr[i]) + cwv[0][1] * bflo(zr[i + 1]) + cwv[0][2] * bflo(zr[i + 2]) + cwv[0][3] * bflo(zr[i + 3]); \
            const float x1 = cbv[1] + cwv[1][0] * bfhi(zr[i]) + cwv[1][1] * bfhi(zr[i + 1]) + cwv[1][2] * bfhi(zr[i + 2]) + cwv[1][3] * bfhi(zr[i + 3]); \
            const int tt = 8 * tg + i; *(LAS unsigned*)(lds + RXB + tt * 144 + cp * 4) = pg8::cvt_pk_bf16(x0, x1); \
            if ((cp >> 4) == hf) { f32x2 xx; xx.x = x0; xx.y = x1; *(LAS f32x2*)(lds + RXF + tt * 128 + (cp & 15) * 8) = xx; } } } while (0)
#define RG_GATES() do { f32x4v ga[2], gx[2]; _Pragma("unroll") for (int nt = 0; nt < 2; ++nt) { ga[nt] = (f32x4v){0.f, 0.f, 0.f, 0.f}; gx[nt] = (f32x4v){0.f, 0.f, 0.f, 0.f}; } \
        _Pragma("unroll") for (int ks = 0; ks < 2; ++ks) { const bf16x8 af = *(const LAS bf16x8*)(lds + RXB + (16 * wave + l15) * 144 + 64 * ks + 16 * q4); \
            _Pragma("unroll") for (int nt = 0; nt < 2; ++nt) { ga[nt] = MFMA16(af, wfa[nt][ks], ga[nt]); gx[nt] = MFMA16(af, wfx[nt][ks], gx[nt]); } } \
        _Pragma("unroll") for (int nt = 0; nt < 2; ++nt) _Pragma("unroll") for (int r = 0; r < 4; ++r) { const int tt = 16 * wave + 4 * q4 + r, cc = 16 * nt + l15; \
            const float xv = *(LAS float*)(lds + RXF + tt * 128 + cc * 4); \
            const float la = -c8l[nt] * sigm(ga[nt][r] + bal[nt]); const float av = __builtin_amdgcn_exp2f(la); \
            const float bv = __builtin_amdgcn_sqrtf(fmaxf(1.0f - av * av, 0.f)) * sigm(gx[nt][r] + bxl[nt]) * xv; \
            *(LAS float*)(lds + RAA + tt * 128 + cc * 4) = av; *(LAS float*)(lds + RBB + tt * 128 + cc * 4) = bv; } } while (0)
        LBAR();
        if (tid < 32) *(LAS float*)(lds + RCARRY + tid * 4) = 0.f;
        RG_LOAD(0); RG_CONV(); RG_LOAD(1);
        LBAR();
        RG_GATES();
        LBAR();
        for (int n = 0; n < 34; ++n) {
            RG_TILE(n, t0, rbase, len); (void)len;
            float av[8], bv[8]; float Pp = 1.f, Hl = 0.f;
#pragma unroll
            for (int ii = 0; ii < 8; ++ii) { const int i = d ? 7 - ii : ii; const int tt = 8 * sub + i;
                const float a = *(LAS float*)(lds + RAA + tt * 128 + sc * 4), b = *(LAS float*)(lds + RBB + tt * 128 + sc * 4);
                av[ii] = a; bv[ii] = b; Hl = a * Hl + b; Pp *= a; }
            { f32x2 ph; ph.x = Pp; ph.y = Hl; *(LAS f32x2*)(lds + RCAR + (sub * 32 + sc) * 8) = ph; }
            unsigned short gr[8], hr[8];
            if (d == 1) {
#pragma unroll
                for (int ii = 0; ii < 8; ++ii) { const long ro = rbase + t0 + 8 * sub + (7 - ii); gr[ii] = zg[ro * INW]; hr[ii] = rp[ro * D]; }
            }
            { RG_CONV(); const int nn = (n + 2 < 34) ? n + 2 : 33; RG_LOAD(nn); }
            LBAR();
            float hin = *(LAS float*)(lds + RCARRY + ((n & 1) * 32 + sc) * 4);
#pragma unroll
            for (int idx = 0; idx < 16; ++idx) { const int s2 = d ? 15 - idx : idx; const f32x2 ph = *(LAS f32x2*)(lds + RCAR + (s2 * 32 + sc) * 8);
                const bool use = d ? (s2 > sub) : (s2 < sub); hin = use ? ph.x * hin + ph.y : hin; }
            float outv[8];
#pragma unroll
            for (int ii = 0; ii < 8; ++ii) { hin = av[ii] * hin + bv[ii];
                if (d == 0) outv[ii] = hin;
                else { const float gg = bf1(gr[ii]); const float uu = 1.5957691216057308f * (gg + 0.044715f * gg * gg * gg);
                       outv[ii] = gg * sigm(uu) * (bf1(hr[ii]) + hin); } }
#pragma unroll
            for (int ii = 0; ii < 8; ii += 2) { const unsigned w = pg8::cvt_pk_bf16(outv[ii], outv[ii + 1]);
                const long ro0 = rbase + t0 + 8 * sub + (d ? 7 - ii : ii), ro1 = rbase + t0 + 8 * sub + (d ? 6 - ii : ii + 1);
                rp[ro0 * D] = (bf16_t)(w & 0xffffu); rp[ro1 * D] = (bf16_t)(w >> 16); }
            if ((d == 0 && sub == 15) || (d == 1 && sub == 0)) *(LAS float*)(lds + RCARRY + (((n + 1) & 1) * 32 + sc) * 4) = hin;
            { RG_GATES(); }
            LBAR();
        }
#undef RG_TILE
#undef RG_LOAD
#undef RG_CONV
#undef RG_GATES
    }
}

#define XB_TMO      128
#define XB_XCNT(j)  (256  + 64 * (j))
#define XB_XSUB(j)  (1280 + 64 * (j))
#define XB_XGEN(j)  (2304 + 64 * (j))
#define XB_TOP      3328
#define XB_TOPGEN   3392
#define XCD_BAR_WORDS 3456
#define XB_SPIN_CAP (1u << 18)

__device__ __forceinline__ unsigned xb_ld(unsigned* p)              { return __hip_atomic_load(p, __ATOMIC_RELAXED, __HIP_MEMORY_SCOPE_AGENT); }
__device__ __forceinline__ unsigned xb_add(unsigned* p, unsigned v) { return __hip_atomic_fetch_add(p, v, __ATOMIC_RELAXED, __HIP_MEMORY_SCOPE_AGENT); }
__device__ __forceinline__ unsigned xb_xcc_id() { return (unsigned)__builtin_amdgcn_s_getreg((3 << 11) | 20) & 0xFu; }
#define XB_SPIN(cond, bar) do { unsigned _sp = 0; while (cond) { __builtin_amdgcn_s_sleep(1); \
    if ((++_sp & 255u) == 0u) { if (xb_ld(&(bar)[XB_TMO])) break; if (_sp > XB_SPIN_CAP) { atomicAdd(&(bar)[XB_TMO], 1u); break; } } } } while (0)

struct XcdBarrier {
    unsigned* bar; unsigned x;
    volatile LAS unsigned* st;
};

__device__ __forceinline__ XcdBarrier xcd_barrier_post(unsigned* bar, volatile LAS unsigned* st) {
    XcdBarrier b; b.bar = bar; b.x = xb_xcc_id(); b.st = st;
    if (tid_opaque() == 0) (void)xb_add(&bar[XB_XCNT(b.x)], 1u);
    return b;
}
__device__ __forceinline__ void xcd_barrier_complete(unsigned* bar, unsigned x, unsigned& nloc, unsigned& nx) {
    const unsigned G = gridDim.x * gridDim.y * gridDim.z;
    unsigned sum, cnt, mine, sp = 0u;
    for (;;) {
        sum = 0u; cnt = 0u; mine = 0u;
#pragma unroll
        for (unsigned j = 0; j < 16; ++j) { const unsigned c = xb_ld(&bar[XB_XCNT(j)]); sum += c; cnt += (c > 0u) ? 1u : 0u; mine = (j == x) ? c : mine; }
        if (sum == G) break;
        __builtin_amdgcn_s_sleep(1);
        if ((++sp & 255u) == 0u) { if (xb_ld(&bar[XB_TMO])) break; if (sp > XB_SPIN_CAP) { atomicAdd(&bar[XB_TMO], 1u); break; } }
    }
    nloc = mine > 0u ? mine : 1u; nx = cnt > 0u ? cnt : 1u;
}

__device__ __forceinline__ void xcd_barrier(const XcdBarrier& b) {
    asm volatile("s_waitcnt vmcnt(0)" ::: "memory");
    __syncthreads();
    if (tid_opaque() == 0) {
        unsigned* bar = b.bar;
        __builtin_amdgcn_s_waitcnt(0);
        unsigned nloc = b.st[0], nx = b.st[1];
        if (nloc == 0u) { xcd_barrier_complete(bar, b.x, nloc, nx); b.st[0] = nloc; b.st[1] = nx; }
        const unsigned old = xb_add(&bar[XB_XSUB(b.x)], 1u);
        const unsigned gen = old / nloc;
        if (old + 1u == (gen + 1u) * nloc) {
            __builtin_amdgcn_fence(__ATOMIC_RELEASE, "agent");
            asm volatile("s_waitcnt vmcnt(0)" ::: "memory");
            const unsigned og = xb_add(&bar[XB_TOP], 1u);
            const unsigned tg = og / nx;
            if (og + 1u == (tg + 1u) * nx) xb_add(&bar[XB_TOPGEN], 1u);
            else XB_SPIN(xb_ld(&bar[XB_TOPGEN]) == tg, bar);
            __builtin_amdgcn_fence(__ATOMIC_ACQUIRE, "agent");
            xb_add(&bar[XB_XGEN(b.x)], 1u);
            asm volatile("s_waitcnt vmcnt(0)" ::: "memory");
        } else {
            XB_SPIN(xb_ld(&bar[XB_XGEN(b.x)]) == gen, bar);
            __builtin_amdgcn_fence(__ATOMIC_ACQUIRE, "agent");
            asm volatile("s_waitcnt vmcnt(0)" ::: "memory");
        }
    }
    __syncthreads();
}

struct Args { Ptrs p; int lo, hi; };
__global__ void __launch_bounds__(NTHREADS, 2) mega_fwd(Args args) {
    extern __shared__ __attribute__((aligned(16))) unsigned char lds_raw[];
    cg::grid_group grid = cg::this_grid();
    lptr lds = (lptr)lds_raw;
    const int lo = args.lo, hi = args.hi;
    typedef const Args __attribute__((address_space(4)))* kargp_t;
#define KP() ({ kargp_t _p = (kargp_t)__builtin_amdgcn_kernarg_segment_ptr(); asm volatile("" : "+s"(_p)); _p; })
#define GETP() Ptrs P; { kargp_t _kp = KP(); const unsigned long long* _src = (const unsigned long long*)_kp; unsigned long long* _dst = (unsigned long long*)&P; _Pragma("unroll") for (int _i = 0; _i < 29; ++_i) _dst[_i] = _src[_i]; } GAS unsigned char* ws = P.ws;
    int ph = 0;
    { volatile LAS unsigned* st0 = (volatile LAS unsigned*)(lds + XB_LDS_OFF); if (tid_opaque() < 2) st0[tid_opaque()] = 0u; }
    __syncthreads();
    XcdBarrier xbar = xcd_barrier_post((unsigned*)args.p.ws, (volatile LAS unsigned*)(lds + XB_LDS_OFF));
#define RUN (ph >= lo && ph < hi)
#define SEAM() do { ++ph; if (ph > lo && ph < hi) { if (ph == 1) grid.sync(); else xcd_barrier(xbar); } } while (0)
#define BUFS() GAS bf16_t* H = (GAS bf16_t*)(ws + WS_H); GAS bf16_t* R0 = (GAS bf16_t*)(ws + WS_R0); GAS bf16_t* OF = (GAS bf16_t*)(ws + WS_OF); GAS bf16_t* OB = (GAS bf16_t*)(ws + WS_OB); GAS bf16_t* Z = (GAS bf16_t*)(ws + WS_Z); GAS bf16_t* ACT = Z; (void)H; (void)R0; (void)OF; (void)OB; (void)ACT;
    const int G = gridDim.x, bid = blockIdx.x;

    if (RUN) { GETP(); BUFS(); mods_phase(P, lds); __syncthreads(); convert_weights(P, lds, 0); }
    SEAM();
    if (RUN) { GETP(); BUFS(); rowop_phase(P, 0, 0, 0); }
    SEAM();
    for (int g = 0; g < NGRP; ++g) {
        for (int l = 0; l < DEPTH; ++l) {
            const bool last = (l == DEPTH - 1);
            const int roff = last ? RC : 0, Mm = last ? RL : MG;
            if (RUN) { GETP(); BUFS(); pg8::Gemm gm{(const bf16_t*)(H), (const bf16_t*)(ws + WS_WIN), MG, INW, D}; pg8::StaticOrder S; S.init(MG, INW, G, bid); EpiZ E{Z, (const GAS float*)(ws + WS_LB) + l * 1024}; pg8::gemm_phase<EpiZ, pg8::StaticOrder>(lds, gm, S, E); }
            SEAM();
            if (RUN) { GETP(); BUFS(); const int vb = (G % 8 == 0) ? (bid % 8) * (G / 8) + bid / 8 : bid;
                       for (int u = vb; u < 256; u += G) hg_unit(P, lds, l, u);
                       for (int u = vb; u < 256; u += G) rg_unit(P, lds, l, u); }
            SEAM();
            if (RUN) { GETP(); BUFS(); pg8::StaticOrder S; S.init(Mm, D, G, bid);
                { pg8::Gemm gm{(const bf16_t*)(R0 + (size_t)roff * D), (const bf16_t*)(ws + WS_WPRG), Mm, D, D}; EpiGate<0> E{Z + O_GA, nullptr, H, roff}; pg8::gemm_phase<EpiGate<0>, pg8::StaticOrder>(lds, gm, S, E); }
                const int nun = (Mm / 256) * (D / 256); const int extra = (nun % G != 0 && G > 64) ? (nun % G) : 0;
                hgout_phase(P, l, extra <= G / 2 ? extra : 0); }
            SEAM();
            if (RUN) { GETP(); BUFS(); pg8::StaticOrder S; S.init(Mm, D, G, bid);
                { pg8::Gemm gm{(const bf16_t*)(OF + (size_t)roff * D), (const bf16_t*)(ws + WS_WPHG), Mm, D, D}; EpiGate<1> E{Z + O_GB, H, OB, roff}; pg8::gemm_phase<EpiGate<1>, pg8::StaticOrder>(lds, gm, S, E); } }
            SEAM();
            if (RUN) { GETP(); BUFS(); pg8::Gemm gm{(const bf16_t*)(OB + (size_t)roff * D), (const bf16_t*)(ws + WS_WOUT), Mm, D, D}; pg8::StaticOrder S; S.init(Mm, D, G, bid); EpiStore E{OF, D, roff}; pg8::gemm_phase<EpiStore, pg8::StaticOrder>(lds, gm, S, E); }
            SEAM();
            if (RUN) { GETP(); BUFS(); rowop_phase(P, 1, g, l); }
            SEAM();
            if (RUN) { GETP(); BUFS(); const int xoff = last ? RCX : 0, Mu = last ? RL : MGX;
                pg8::Gemm gm{(const bf16_t*)(H + (size_t)xoff * D), (const bf16_t*)(ws + WS_WUP), Mu, NUP, D}; pg8::StaticOrder S; S.init(Mu, NUP, G, bid);
                EpiUp E{ACT, P.ffn_conv_w + (size_t)l * 3 * DFF, P.ffn_conv_b + (size_t)l * DFF, last ? 10 : 0}; pg8::gemm_phase<EpiUp, pg8::StaticOrder>(lds, gm, S, E); }
            SEAM();
            if (RUN) { GETP(); BUFS(); pg8::Gemm gm{(const bf16_t*)(ACT + (size_t)roff * DFF), (const bf16_t*)(ws + WS_WDN), Mm, D, DFF}; pg8::StaticOrder S; S.init(Mm, D, G, bid); EpiStore E{OF, D, roff}; pg8::gemm_phase<EpiStore, pg8::StaticOrder>(lds, gm, S, E);
                const int nun = (Mm / 256) * (D / 256); const int extra = (nun % G != 0 && G > 64 && (nun % G) <= G / 2) ? (nun % G) : 0;
                LBAR();
                if (!last) convert_weights(P, lds, l + 1, 1, extra); else if (g + 1 < NGRP) convert_weights(P, lds, 0, 1, extra); }
            SEAM();
            if (RUN) { GETP(); BUFS(); rowop_phase(P, 2, g, l);
                if (!last) convert_weights(P, lds, l + 1, 2);
                else if (g + 1 < NGRP) { convert_weights(P, lds, 0, 2); rowop_phase(P, 0, g + 1, 0); } }
            SEAM();
        }
    }
#undef RUN
#undef SEAM
}
constexpr int N_PHASES = 2 + NGRP * DEPTH * 9;

extern "C" void kernel_launch(void* const* d_in, const int* in_sizes, int n_in, void* d_out, int out_size, void* d_ws, size_t ws_size, hipStream_t stream) {
    static int grid = 0;
    if (grid == 0) {
        if (n_in != 27 || ws_size < WS_END) { fprintf(stderr, "kernel_launch: unexpected n_in %d or ws_size %zu (< %zu)\n", n_in, ws_size, (size_t)WS_END); grid = -1; return; }
        int dev = 0, cus = 0, per_cu = 0;
        (void)hipGetDevice(&dev);
        (void)hipDeviceGetAttribute(&cus, hipDeviceAttributeMultiprocessorCount, dev);
        if (hipFuncSetAttribute((const void*)mega_fwd, hipFuncAttributeMaxDynamicSharedMemorySize, LDS_BYTES) != hipSuccess) { fprintf(stderr, "kernel_launch: hipFuncSetAttribute failed\n"); grid = -1; return; }
        if (hipOccupancyMaxActiveBlocksPerMultiprocessor(&per_cu, (const void*)mega_fwd, NTHREADS, LDS_BYTES) != hipSuccess || per_cu < 1) { fprintf(stderr, "kernel_launch: occupancy query says %d\n", per_cu); per_cu = 1; }
        (void)hipGetLastError();
        grid = cus * 1;
        fprintf(stderr, "kernel_launch: cus %d per_cu %d grid %d\n", cus, per_cu, grid);
    }
    if (grid < 0) return;
    if (hipMemsetAsync(d_ws, 0, 65536, stream) != hipSuccess) { fprintf(stderr, "kernel_launch: memset failed\n"); return; }
    Args a{};
    const GAS float** pp = (const GAS float**)&a.p;
    for (int i = 0; i < 27; ++i) pp[i] = (const GAS float*)d_in[i];
    a.p.out = (GAS float*)d_out; a.p.ws = (GAS unsigned char*)d_ws;
#ifdef MULTI_LAUNCH
    for (int p = 0; p < N_PHASES; ++p) { a.lo = p; a.hi = p + 1; hipLaunchKernelGGL(mega_fwd, dim3(grid), dim3(NTHREADS), LDS_BYTES, stream, a); }
#else
    a.lo = 0; a.hi = N_PHASES;
    void* kargs[] = {&a};
    hipError_t e = hipLaunchCooperativeKernel((void*)mega_fwd, dim3(grid), dim3(NTHREADS), kargs, LDS_BYTES, stream);
    if (e != hipSuccess) fprintf(stderr, "cooperative launch failed: %s (grid %d)\n", hipGetErrorString(e), grid);
#endif
}
```

```cpp
#include <hip/hip_runtime.h>
#include <hip/hip_cooperative_groups.h>
#include <cstdio>
namespace cg = cooperative_groups;
__device__ __forceinline__ int tid_opaque() { int t = threadIdx.x; asm volatile("" : "+v"(t)); return t; }
namespace pg8 {
#define PG8_LAS __attribute__((address_space(3)))
typedef unsigned short bf16_t;
typedef short bf16x8 __attribute__((ext_vector_type(8)));
typedef float f32x4 __attribute__((ext_vector_type(4)));
typedef unsigned u32x4 __attribute__((ext_vector_type(4)));
constexpr int BM = 256, BK = 64, HALF = 128, HTB = HALF * BK * 2  , STAGE_BYTES = 8 * HTB, NXCD = 8, WGM = 8;

__host__ __device__ __forceinline__ int lds_byte(int r, int c) { const int st = (r >> 4) * 2 + (c >> 5), rr = r & 15, cc = c & 31, ob = rr * 64 + cc * 2; return st * 1024 + (ob ^ (((ob >> 9) & 1) << 5)); }
__host__ __device__ __forceinline__ void stage_rc(int b, int& R, int& C) { const int st = b / 1024, sb = b % 1024, swz = sb ^ (((sb >> 9) & 1) << 5); R = (st >> 1) * 16 + swz / 64; C = (st & 1) * 32 + (swz % 64) / 2; }
__host__ __device__ __forceinline__ int perm32(int rho) { const int n = rho >> 4, i = rho & 15; return 8 * (i >> 2) + 4 * n + (i & 3); }

struct Unit { int pm, pn; };
struct Gemm { const bf16_t* A; const bf16_t* Bt; int M, N, K; };

struct StaticOrder {
    int nM, nN, nwg, G, c;
    __host__ __device__ void init(int M, int N, int G_, int c_) { nM = M / BM; nN = N / BM; nwg = nM * nN; G = G_; c = c_; }
    __host__ __device__ bool next(int i, Unit& u) const {
        const long L = (long)i * G + c; if (L >= nwg) return false;
        int wgid = (int)L; { const int q = nwg / NXCD, r = nwg % NXCD, xcd = wgid % NXCD, off = wgid / NXCD; wgid = (xcd < r ? xcd * (q + 1) : r * (q + 1) + (xcd - r) * q) + off; }
        const int nig = WGM * nN, gid = wgid / nig, fm = gid * WGM, gsz = (nM - fm) < WGM ? (nM - fm) : WGM;
        u.pm = fm + ((wgid % nig) % gsz); u.pn = (wgid % nig) / gsz; return true;
    }
    __device__ __forceinline__ void a_ready(const Unit&) const {}
    __device__ __forceinline__ void done(const Unit&) const {}
};
struct LastLayerOrder {
    StaticOrder lat; int G, c, ct, nlat;
    __host__ __device__ void init(int Mlat, int N, int ctx_tiles, int G_, int c_) { lat.init(Mlat, N, G_, c_); G = G_; c = c_; ct = ctx_tiles; nlat = lat.nwg; }
    __host__ __device__ bool next(int i, Unit& u) const {
        const long L = (long)i * G + c;
        if (L < nlat) { lat.next(i, u); u.pm += ct; return true; }
        const int k = (int)(L - nlat); if (k >= ct * 20) return false;
        u.pm = k / 20; const int j = k % 20; u.pn = j < 4 ? j : j + 4; return true;
    }
    __device__ __forceinline__ void a_ready(const Unit&) const {}
    __device__ __forceinline__ void done(const Unit&) const {}
};
__device__ __forceinline__ unsigned cvt_pk_bf16(float lo, float hi) { unsigned r; asm volatile("v_cvt_pk_bf16_f32 %0, %1, %2" : "=v"(r) : "v"(lo), "v"(hi)); return r; }
template <class Epi, class Sched>
__device__ __forceinline__ void gemm_phase(PG8_LAS unsigned char* lds, const Gemm g, const Sched& S, const Epi& E) {
    const int tid = tid_opaque(), wid = __builtin_amdgcn_readfirstlane(tid >> 6), lane = tid & 63, wr = wid >> 2, wc = wid & 3, fr = lane & 15, fq = lane >> 4;
    const int K = g.K, nt = K / BK;
    unsigned voffA[2], voffB[2];
#pragma unroll
    for (int i = 0; i < 2; ++i) { int R, C; stage_rc(tid * 16 + i * 8192, R, C); const int Rb = Epi::PERM ? ((R & ~31) + perm32(R & 31)) : R;
        voffA[i] = (unsigned)(R * K + C) * 2u; voffB[i] = (unsigned)(Rb * K + C) * 2u; }
    const size_t kstep = (size_t)(BK * 2);
    const size_t hstep = (size_t)HALF * K * 2;
    const size_t tstep = 2 * hstep;
    const unsigned ldsw = (unsigned)wid * 1024u;
    const int aoff = lds_byte(wr * 64 + fr, fq * 8), boff = lds_byte(wc * 32 + fr, fq * 8);
#define PG8_SA(b, h) (((b) * 2 + (h)) * HTB)
#define PG8_SB(b, h) ((4 + (b) * 2 + (h)) * HTB)
#define PG8_STAGE(bufoff, gbase, voff) do { _Pragma("unroll") for (int _i = 0; _i < 2; ++_i) \
        __builtin_amdgcn_global_load_lds((const unsigned*)((const char*)(gbase) + (voff)[_i]), (PG8_LAS unsigned*)(lds + (bufoff) + ldsw + _i * 8192), 16, 0, 0); } while (0)
#define PG8_LDA(dst, b, h) do { _Pragma("unroll") for (int m = 0; m < 4; ++m) _Pragma("unroll") for (int k = 0; k < 2; ++k) dst[m][k] = *(const PG8_LAS bf16x8*)(lds + PG8_SA(b, h) + aoff + m * 2048 + k * 1024); } while (0)
#define PG8_LDB(dst, b, h) do { _Pragma("unroll") for (int n = 0; n < 2; ++n) _Pragma("unroll") for (int k = 0; k < 2; ++k) dst[n][k] = *(const PG8_LAS bf16x8*)(lds + PG8_SB(b, h) + boff + n * 2048 + k * 1024); } while (0)
#define PG8_MMA(ai, bj, At, Bt) do { __builtin_amdgcn_s_setprio(1); _Pragma("unroll") for (int m = 0; m < 4; ++m) _Pragma("unroll") for (int n = 0; n < 2; ++n) _Pragma("unroll") for (int k = 0; k < 2; ++k) \
        acc[ai][bj][m][n] = __builtin_amdgcn_mfma_f32_16x16x32_bf16(Bt[n][k], At[m][k], acc[ai][bj][m][n], 0, 0, 0); __builtin_amdgcn_s_setprio(0); } while (0)
#define PG8_WAIT_V(n) asm volatile("s_waitcnt vmcnt(" #n ")" ::: "memory")
#define PG8_WAIT_L(n) asm volatile("s_waitcnt lgkmcnt(" #n ")" ::: "memory")
#define PG8_BAR __builtin_amdgcn_s_barrier()
#define PG8_SCHED __builtin_amdgcn_sched_barrier(0)
    Unit cur, nxt; int ui = 0;
    if (!S.next(0, cur)) return;
    f32x4 acc[2][2][4][2];
#pragma unroll
    for (int a = 0; a < 2; ++a)
#pragma unroll
        for (int b = 0; b < 2; ++b)
#pragma unroll
            for (int m = 0; m < 4; ++m)
#pragma unroll
                for (int n = 0; n < 2; ++n) acc[a][b][m][n] = (f32x4){0.f, 0.f, 0.f, 0.f};
    bf16x8 At[4][2], B0[2][2], B1[2][2];
    const char* cA = (const char*)g.A + (size_t)cur.pm * tstep; const char* cB = (const char*)g.Bt + (size_t)cur.pn * tstep;
    S.a_ready(cur);
    PG8_STAGE(PG8_SB(0, 0), cB, voffB); PG8_STAGE(PG8_SA(0, 0), cA, voffA); PG8_STAGE(PG8_SB(0, 1), cB + hstep, voffB); PG8_STAGE(PG8_SA(0, 1), cA + hstep, voffA);
    if (wr == 1) PG8_BAR;
    PG8_WAIT_V(4); PG8_BAR;
    PG8_STAGE(PG8_SB(1, 0), cB + kstep, voffB); PG8_STAGE(PG8_SA(1, 0), cA + kstep, voffA); PG8_STAGE(PG8_SB(1, 1), cB + hstep + kstep, voffB);
    PG8_WAIT_V(6); PG8_BAR;
    for (;;) {
        const bool has_next = S.next(ui + 1, nxt);
        const char* nA = has_next ? (const char*)g.A + (size_t)nxt.pm * tstep : cA; const char* nB = has_next ? (const char*)g.Bt + (size_t)nxt.pn * tstep : cB;
        for (int t = 0; t < nt; t += 2) {
            const bool last = (t == nt - 2);
            const char* a1 = cA + (size_t)(t + 1) * kstep;
            const char* a2 = last ? nA : cA + (size_t)(t + 2) * kstep; const char* b2 = last ? nB : cB + (size_t)(t + 2) * kstep;
            const char* a3 = a2 + kstep; const char* b3 = b2 + kstep;
            if (last && has_next) S.a_ready(nxt);
            PG8_LDB(B0, 0, 0); PG8_SCHED; PG8_LDA(At, 0, 0); PG8_STAGE(PG8_SA(1, 1), a1 + hstep, voffA);
            PG8_WAIT_L(8); PG8_BAR; PG8_WAIT_L(0); PG8_MMA(0, 0, At, B0); PG8_BAR; PG8_SCHED;
            PG8_LDB(B1, 0, 1); PG8_STAGE(PG8_SB(0, 0), b2, voffB);
            PG8_BAR; PG8_WAIT_L(0); PG8_MMA(0, 1, At, B1); PG8_BAR;
            PG8_LDA(At, 0, 1); PG8_STAGE(PG8_SA(0, 0), a2, voffA);
            PG8_BAR; PG8_WAIT_L(0); PG8_MMA(1, 0, At, B0); PG8_BAR; PG8_SCHED;
            PG8_STAGE(PG8_SB(0, 1), b2 + hstep, voffB);
            PG8_WAIT_V(6); PG8_BAR; PG8_MMA(1, 1, At, B1); PG8_BAR;
            PG8_LDB(B0, 1, 0); PG8_SCHED; PG8_LDA(At, 1, 0); PG8_STAGE(PG8_SA(0, 1), a2 + hstep, voffA);
            PG8_WAIT_L(8); PG8_BAR; PG8_WAIT_L(0); PG8_MMA(0, 0, At, B0); PG8_BAR; PG8_SCHED;
            PG8_LDB(B1, 1, 1); PG8_STAGE(PG8_SB(1, 0), b3, voffB);
            PG8_BAR; PG8_WAIT_L(0); PG8_MMA(0, 1, At, B1); PG8_BAR;
            PG8_LDA(At, 1, 1); PG8_STAGE(PG8_SA(1, 0), a3, voffA);
            PG8_BAR; PG8_WAIT_L(0); PG8_MMA(1, 0, At, B0); PG8_BAR; PG8_SCHED;
            PG8_STAGE(PG8_SB(1, 1), b3 + hstep, voffB);
            PG8_WAIT_V(6); PG8_BAR; PG8_MMA(1, 1, At, B1); PG8_BAR;
        }
        if constexpr (!Epi::AFTER_DRAIN) { E(acc, cur, wr, wc, fr, fq); S.done(cur); }
        if (!has_next) break;
#pragma unroll
        for (int a = 0; a < 2; ++a)
#pragma unroll
            for (int b = 0; b < 2; ++b)
#pragma unroll
                for (int m = 0; m < 4; ++m)
#pragma unroll
                    for (int n = 0; n < 2; ++n) acc[a][b][m][n] = (f32x4){0.f, 0.f, 0.f, 0.f};
        cur = nxt; cA = nA; cB = nB; ++ui;
    }
    PG8_WAIT_V(0);
    if (wr == 0) PG8_BAR;
    PG8_BAR;
    if constexpr (Epi::AFTER_DRAIN) { E.fused(acc, cur, wr, wc, fr, fq, lds, wid, lane); S.done(cur); }
#undef PG8_SA
#undef PG8_SB
#undef PG8_STAGE
#undef PG8_LDA
#undef PG8_LDB
#undef PG8_MMA
#undef PG8_WAIT_V
#undef PG8_WAIT_L
#undef PG8_BAR
#undef PG8_SCHED
}
}
#define LAS __attribute__((address_space(3)))
#define GAS __attribute__((address_space(1)))
typedef unsigned short bf16_t;
typedef short bf16x8 __attribute__((ext_vector_type(8)));
typedef float f32x4 __attribute__((ext_vector_type(4)));
typedef float f32x2 __attribute__((ext_vector_type(2)));
typedef float f32x16 __attribute__((ext_vector_type(16)));
typedef unsigned u32x4 __attribute__((ext_vector_type(4)));
typedef unsigned u32x2 __attribute__((ext_vector_type(2)));
typedef LAS unsigned char* lptr;

constexpr int D = 1024, NB = 16, SEQ = 4096, CTX = 256, DEPTH = 4;
constexpr int GB = 8, NGRP = 2;
constexpr int RC = GB * CTX;
constexpr int RL = GB * SEQ;
constexpr int MG = RC + RL;
constexpr int RCX = GB * 320;
constexpr int MGX = RCX + RL;
constexpr int INW = 9216, DFF = 2816, NUP = 2 * DFF;
constexpr int O_RGX = 0, O_RGG = 1024, O_HG = 2048, O_GA = 7168, O_GB = 8192;
constexpr float EPS = 1e-6f;
constexpr int NTHREADS = 512;
constexpr int LDS_BYTES = 147456;
constexpr int XB_LDS_OFF = 147456 - 64;

constexpr size_t MiB = 1u << 20;
constexpr size_t WS_MOD = 1 * MiB;
constexpr size_t WS_LB = 2 * MiB + 768 * 1024;
constexpr size_t WS_XC = 3 * MiB;
constexpr size_t WS_WIN = 19 * MiB;
constexpr size_t WS_WPRG = 37 * MiB, WS_WPHG = 39 * MiB, WS_WOUT = 41 * MiB;
constexpr size_t WS_WUP = 43 * MiB;
constexpr size_t WS_WDN = 54 * MiB;
constexpr size_t WS_H = 60 * MiB;
constexpr size_t WS_R0 = 129 * MiB;
constexpr size_t WS_OF = 197 * MiB;
constexpr size_t WS_OB = 265 * MiB;
constexpr size_t WS_Z = 333 * MiB;
constexpr size_t WS_END = 945 * MiB;

__device__ __forceinline__ unsigned f2bf(float f) { unsigned u = __float_as_uint(f); return (u + 0x7fffu + ((u >> 16) & 1u)) >> 16; }
__device__ __forceinline__ unsigned pk2(float lo, float hi) { unsigned r; asm("v_cvt_pk_bf16_f32 %0, %1, %2" : "=v"(r) : "v"(lo), "v"(hi)); return r; }
__device__ __forceinline__ float bflo(unsigned w) { return __uint_as_float(w << 16); }
__device__ __forceinline__ float bfhi(unsigned w) { return __uint_as_float(w & 0xffff0000u); }
__device__ __forceinline__ float bf1(unsigned short s) { return __uint_as_float(((unsigned)s) << 16); }
__device__ __forceinline__ float sigm(float x) { return __builtin_amdgcn_rcpf(1.0f + __builtin_amdgcn_exp2f(-1.4426950408889634f * x)); }
__device__ __forceinline__ float wave_sum(float v) {
#pragma unroll
    for (int o = 1; o < 64; o <<= 1) v += __shfl_xor(v, o);
    return v;
}
#define LBAR() do { asm volatile("s_waitcnt lgkmcnt(0)" ::: "memory"); __builtin_amdgcn_s_barrier(); asm volatile("" ::: "memory"); } while (0)
#define MFMA32(a, b, c) __builtin_amdgcn_mfma_f32_32x32x16_bf16((a), (b), (c), 0, 0, 0)
__device__ __forceinline__ int crow(int reg, int h) { return (reg & 3) + 8 * (reg >> 2) + 4 * h; }

struct EpiStore {
    static constexpr bool PERM = true, AFTER_DRAIN = false;
    GAS bf16_t* O; int ldc; int row_off;
    __device__ __forceinline__ void operator()(const f32x4 (&acc)[2][2][4][2], const pg8::Unit& u, int wr, int wc, int fr, int fq) const {
        const int row0 = row_off + u.pm * 256 + wr * 64 + fr, col0 = u.pn * 256 + wc * 32 + 8 * fq;
#pragma unroll
        for (int ai = 0; ai < 2; ++ai)
#pragma unroll
            for (int m = 0; m < 4; ++m) { GAS bf16_t* rowp = O + (size_t)(row0 + ai * 128 + m * 16) * ldc + col0;
#pragma unroll
                for (int bj = 0; bj < 2; ++bj) { const f32x4 v0 = acc[ai][bj][m][0], v1 = acc[ai][bj][m][1];
                    u32x4 w; w.x = pg8::cvt_pk_bf16(v0[0], v0[1]); w.y = pg8::cvt_pk_bf16(v0[2], v0[3]); w.z = pg8::cvt_pk_bf16(v1[0], v1[1]); w.w = pg8::cvt_pk_bf16(v1[2], v1[3]);
                    *(GAS u32x4*)(rowp + bj * 128) = w; } }
    }
};
struct EpiZ {
    static constexpr bool PERM = true, AFTER_DRAIN = false;
    GAS bf16_t* O; const GAS float* lb;
    __device__ __forceinline__ void operator()(const f32x4 (&acc)[2][2][4][2], const pg8::Unit& u, int wr, int wc, int fr, int fq) const {
        const int row0 = u.pm * 256 + wr * 64 + fr, col0 = u.pn * 256 + wc * 32 + 8 * fq;
        const int ct = u.pn * 256;
        const int mode = (ct >= O_HG && ct < O_HG + 1024) ? 1 : ((ct >= O_HG + 1024 && ct < O_HG + 3072) ? 2 : 0);
        float lbv[2][8];
        if (mode == 2) {
#pragma unroll
            for (int bj = 0; bj < 2; ++bj) { const GAS float* lp = lb + ((col0 + bj * 128) & 1023); const f32x4 a = *(const GAS f32x4*)lp, b = *(const GAS f32x4*)(lp + 4);
#pragma unroll
                for (int j = 0; j < 4; ++j) { lbv[bj][j] = a[j]; lbv[bj][4 + j] = b[j]; } }
        }
#pragma unroll
        for (int ai = 0; ai < 2; ++ai)
#pragma unroll
            for (int m = 0; m < 4; ++m) { GAS bf16_t* rowp = O + (size_t)(row0 + ai * 128 + m * 16) * INW + col0;
#pragma unroll
                for (int bj = 0; bj < 2; ++bj) { const f32x4 v0 = acc[ai][bj][m][0], v1 = acc[ai][bj][m][1];
                    float o[8] = {v0[0], v0[1], v0[2], v0[3], v1[0], v1[1], v1[2], v1[3]};
                    u32x4 w;
                    if (mode == 2) { unsigned hb[8];
#pragma unroll
                        for (int j = 0; j < 8; ++j) { const float z = fminf(fmaxf(o[j], -30.f), 30.f); const float lbj = lbv[bj][j]; const float lf = __builtin_amdgcn_logf(lbj + (1.0f - lbj) * sigm(z));
                            hb[j] = (unsigned)__builtin_bit_cast(unsigned short, (_Float16)lf); }
                        w.x = hb[0] | (hb[1] << 16); w.y = hb[2] | (hb[3] << 16); w.z = hb[4] | (hb[5] << 16); w.w = hb[6] | (hb[7] << 16);
                    } else {
                        if (mode == 1) {
#pragma unroll
                            for (int j = 0; j < 8; ++j) o[j] = o[j] * sigm(o[j]); }
                        w.x = pg8::cvt_pk_bf16(o[0], o[1]); w.y = pg8::cvt_pk_bf16(o[2], o[3]); w.z = pg8::cvt_pk_bf16(o[4], o[5]); w.w = pg8::cvt_pk_bf16(o[6], o[7]);
                    }
                    *(GAS u32x4*)(rowp + bj * 128) = w; } }
    }
};
template <int MODE> struct EpiGate {
    static constexpr bool PERM = true, AFTER_DRAIN = false;
    const GAS bf16_t* Zg; const GAS bf16_t* T; GAS bf16_t* O; int row_off;
    __device__ __forceinline__ void operator()(const f32x4 (&acc)[2][2][4][2], const pg8::Unit& u, int wr, int wc, int fr, int fq) const {
        const int row0 = row_off + u.pm * 256 + wr * 64 + fr, col0 = u.pn * 256 + wc * 32 + 8 * fq;
#pragma unroll
        for (int ai = 0; ai < 2; ++ai) {
            u32x4 gw[4][2], tw[4][2];
#pragma unroll
            for (int m = 0; m < 4; ++m)
#pragma unroll
                for (int bj = 0; bj < 2; ++bj) { const size_t row = (size_t)(row0 + ai * 128 + m * 16); const int col = col0 + bj * 128;
                    gw[m][bj] = *(const GAS u32x4*)(Zg + row * INW + col); if (MODE == 1) tw[m][bj] = *(const GAS u32x4*)(T + row * D + col); }
#pragma unroll
            for (int m = 0; m < 4; ++m)
#pragma unroll
                for (int bj = 0; bj < 2; ++bj) { const size_t row = (size_t)(row0 + ai * 128 + m * 16); const int col = col0 + bj * 128;
                    const u32x4 g4 = gw[m][bj];
                    const f32x4 v0 = acc[ai][bj][m][0], v1 = acc[ai][bj][m][1];
                    float o[8];
                    o[0] = sigm(bflo(g4.x)) * v0[0]; o[1] = sigm(bfhi(g4.x)) * v0[1]; o[2] = sigm(bflo(g4.y)) * v0[2]; o[3] = sigm(bfhi(g4.y)) * v0[3];
                    o[4] = sigm(bflo(g4.z)) * v1[0]; o[5] = sigm(bfhi(g4.z)) * v1[1]; o[6] = sigm(bflo(g4.w)) * v1[2]; o[7] = sigm(bfhi(g4.w)) * v1[3];
                    if (MODE == 1) { const u32x4 t4 = tw[m][bj];
                        o[0] += bflo(t4.x); o[1] += bfhi(t4.x); o[2] += bflo(t4.y); o[3] += bfhi(t4.y); o[4] += bflo(t4.z); o[5] += bfhi(t4.z); o[6] += bflo(t4.w); o[7] += bfhi(t4.w); }
                    u32x4 w; w.x = pg8::cvt_pk_bf16(o[0], o[1]); w.y = pg8::cvt_pk_bf16(o[2], o[3]); w.z = pg8::cvt_pk_bf16(o[4], o[5]); w.w = pg8::cvt_pk_bf16(o[6], o[7]);
                    *(GAS u32x4*)(O + row * D + col) = w; }
        }
    }
};
struct EpiUp {
    static constexpr bool PERM = true, AFTER_DRAIN = false;
    GAS bf16_t* ACT; const GAS float* cw; const GAS float* cb; int pm_off;
    __device__ __forceinline__ void operator()(const f32x4 (&acc)[2][2][4][2], const pg8::Unit& u, int wr, int wc, int fr, int fq) const {
        const int lane = tid_opaque() & 63;
        const int ch0 = u.pn * 128 + wc * 32 + 8 * fq;
        const int pmv = u.pm + pm_off;
        const int lup = (lane & 48) | ((lane + 1) & 15), ldn = (lane & 48) | ((lane - 1) & 15);
        f32x4 cw0[2], cw1[2], cw2[2], cbb[2];
#pragma unroll
        for (int n = 0; n < 2; ++n) { const int chn = ch0 + 4 * n; cw0[n] = *(const GAS f32x4*)(cw + chn); cw1[n] = *(const GAS f32x4*)(cw + DFF + chn); cw2[n] = *(const GAS f32x4*)(cw + 2 * DFF + chn); cbb[n] = *(const GAS f32x4*)(cb + chn); }
#pragma unroll
        for (int ai = 0; ai < 2; ++ai) {
            long drow[4]; bool ok[4];
#pragma unroll
            for (int m = 0; m < 4; ++m) {
                const int r64 = 16 * m + fr; ok[m] = true;
                if (pmv < 10) { const int G = pmv * 4 + ai * 2 + wr, bl = G / 5, gi = G - bl * 5, tok = 62 * gi - 1 + r64; ok[m] = (r64 >= 1) && (r64 <= 62) && (tok < CTX); drow[m] = (long)bl * CTX + tok; }
                else drow[m] = (long)RC + (long)(pmv - 10) * 256 + ai * 128 + wr * 64 + r64;
            }
            unsigned pw[4][4];
#pragma unroll
            for (int n = 0; n < 2; ++n) {
                const f32x4 w0 = cw0[n], w1 = cw1[n], w2 = cw2[n], bb = cbb[n];
#pragma unroll
                for (int jp = 0; jp < 2; ++jp) {
                    float res[2][4];
#pragma unroll
                    for (int jj = 0; jj < 2; ++jj) { const int j = 2 * jp + jj;
                        float ru[4], rd[4];
#pragma unroll
                        for (int m = 0; m < 4; ++m) { const int gi = __float_as_int(acc[ai][0][m][n][j]);
                            ru[m] = __int_as_float(__builtin_amdgcn_update_dpp(0, gi, 0x12F, 0xf, 0xf, false)); rd[m] = __int_as_float(__builtin_amdgcn_update_dpp(0, gi, 0x121, 0xf, 0xf, false)); }
#pragma unroll
                        for (int m = 0; m < 4; ++m) {
                            const float up = (fr < 15) ? ru[m] : (m < 3 ? ru[m < 3 ? m + 1 : 3] : 0.f);
                            const float dn = (fr > 0) ? rd[m] : (m > 0 ? rd[m > 0 ? m - 1 : 0] : 0.f);
                            const float cv = bb[j] + w0[j] * dn + w1[j] * acc[ai][0][m][n][j] + w2[j] * up;
                            res[jj][m] = cv * sigm(cv) * acc[ai][1][m][n][j];
                        } }
#pragma unroll
                    for (int m = 0; m < 4; ++m) pw[m][2 * n + jp] = pg8::cvt_pk_bf16(res[0][m], res[1][m]);
                }
            }
#pragma unroll
            for (int m = 0; m < 4; ++m) if (ok[m]) { u32x4 w; w.x = pw[m][0]; w.y = pw[m][1]; w.z = pw[m][2]; w.w = pw[m][3]; *(GAS u32x4*)(ACT + (size_t)drow[m] * DFF + ch0) = w; }
        }
    }
};

template <bool UPMAP>
__device__ __forceinline__ void conv_item(const GAS float* W, int K, int N, GAS bf16_t* WT, LAS float* scr, int item, int lane) {
    const int nblk = N / 32, kb = item / nblk, nb = item % nblk, k0 = 64 * kb, n0 = 32 * nb;
    float wv[32];
#pragma unroll
    for (int i = 0; i < 32; ++i) { const int kk = 2 * i + (lane >> 5); wv[i] = __builtin_nontemporal_load(W + (size_t)(k0 + kk) * N + n0 + (lane & 31)); }
#pragma unroll
    for (int i = 0; i < 32; ++i) { const int kk = 2 * i + (lane >> 5); scr[kk * 33 + (lane & 31)] = wv[i]; }
    asm volatile("s_waitcnt lgkmcnt(0)" ::: "memory");
    int d0 = n0;
    if (UPMAP) { if (n0 < DFF) d0 = (n0 >> 7) * 256 + (n0 & 127); else { const int n2 = n0 - DFF; d0 = (n2 >> 7) * 256 + 128 + (n2 & 127); } }
    const int c = lane & 7;
#pragma unroll
    for (int j = 0; j < 4; ++j) { const int n = (lane >> 3) + 8 * j; const LAS float* s = scr + (8 * c) * 33 + n;
        u32x4 o; o.x = pk2(s[0 * 33], s[1 * 33]); o.y = pk2(s[2 * 33], s[3 * 33]); o.z = pk2(s[4 * 33], s[5 * 33]); o.w = pk2(s[6 * 33], s[7 * 33]);
        *(GAS u32x4*)(WT + (size_t)(d0 + n) * K + k0 + 8 * c) = o; }
    asm volatile("s_waitcnt lgkmcnt(0)" ::: "memory");
}
struct Ptrs {
    const GAS float*x, *c, *ctx, *c_ctx, *w_ada, *b_ada, *g_pre_mix, *g_post_mix, *g_pre_ffn, *g_post_ffn, *w_in, *rg_conv_w, *rg_conv_b, *rg_wa, *rg_ba, *rg_wx, *rg_bx, *rg_lam,
        *hg_lb, *hg_out_norm, *w_proj_rg, *w_proj_hg, *w_out, *ffn_w_up, *ffn_conv_w, *ffn_conv_b, *ffn_w_down;
    GAS float* out; GAS unsigned char* ws;
};
__device__ __forceinline__ void convert_weights(const Ptrs& P, lptr lds, int l, int part = 0, int skip = 0) {
    const int lane = tid_opaque() & 63, wave = __builtin_amdgcn_readfirstlane(tid_opaque() >> 6);
    LAS float* scr = (LAS float*)(lds + wave * 8448);
    if ((int)blockIdx.x < skip) return;
    const int gw = ((int)blockIdx.x - skip) * 8 + wave, NGW = ((int)gridDim.x - skip) * 8;
    constexpr int I_IN = 16 * 288, I_P = 16 * 32, I_UP = 16 * 176, I_DN = 44 * 32, NIT = I_IN + 3 * I_P + I_UP + I_DN;
    const int it_lo = (part == 2) ? NIT - I_DN : 0, it_hi = (part == 1) ? NIT - I_DN : NIT;
    for (int it = it_lo + gw; it < it_hi; it += NGW) {
        int r = it;
        if (r < I_IN) { conv_item<false>(P.w_in + (size_t)l * D * INW, D, INW, (GAS bf16_t*)(P.ws + WS_WIN), scr, r, lane); continue; } r -= I_IN;
        if (r < I_P) { conv_item<false>(P.w_proj_rg + (size_t)l * D * D, D, D, (GAS bf16_t*)(P.ws + WS_WPRG), scr, r, lane); continue; } r -= I_P;
        if (r < I_P) { conv_item<false>(P.w_proj_hg + (size_t)l * D * D, D, D, (GAS bf16_t*)(P.ws + WS_WPHG), scr, r, lane); continue; } r -= I_P;
        if (r < I_P) { conv_item<false>(P.w_out + (size_t)l * D * D, D, D, (GAS bf16_t*)(P.ws + WS_WOUT), scr, r, lane); continue; } r -= I_P;
        if (r < I_UP) { conv_item<true>(P.ffn_w_up + (size_t)l * D * NUP, D, NUP, (GAS bf16_t*)(P.ws + WS_WUP), scr, r, lane); continue; } r -= I_UP;
        conv_item<false>(P.ffn_w_down + (size_t)l * DFF * D, DFF, D, (GAS bf16_t*)(P.ws + WS_WDN), scr, r, lane);
    }
}
__device__ __forceinline__ void mods_phase(const Ptrs& P, lptr lds) {
    const int tid = tid_opaque(), lane = tid & 63, wave = __builtin_amdgcn_readfirstlane(tid >> 6);
    LAS float* S = (LAS float*)lds;
    LAS float* RED = (LAS float*)(lds + 17 * 1024 * 4);
    GAS float* MOD = (GAS float*)(P.ws + WS_MOD);
    for (int idx = tid; idx < 17 * 1024; idx += NTHREADS) { const int r = idx >> 10, k = idx & 1023; const float v = r < 16 ? P.c[r * 1024 + k] : P.c_ctx[k]; S[idx] = v * sigm(v); }
    if (blockIdx.x == 0) { GAS float* LB = (GAS float*)(P.ws + WS_LB);
        for (int c = tid; c < 1024; c += NTHREADS) { const float p0 = P.hg_lb[c], p1 = P.hg_lb[1024 + c], p2 = P.hg_lb[2048 + c], p3 = P.hg_lb[3072 + c];
            const float mx = fmaxf(fmaxf(p0, p1), fmaxf(p2, p3)); const float e0 = expf(p0 - mx), e1 = expf(p1 - mx), e2 = expf(p2 - mx), e3 = expf(p3 - mx); const float inv = 1.0f / (e0 + e1 + e2 + e3);
            LB[c] = 0.f; LB[1024 + c] = e1 * inv; LB[2048 + c] = (e1 + e2) * inv; LB[3072 + c] = (e1 + e2 + e3) * inv; } }
    __syncthreads();
    for (int task = blockIdx.x; task < 4 * 96; task += gridDim.x) {
        const int l = task / 96, n0 = (task % 96) * 64;
        float acc[17];
#pragma unroll
        for (int r = 0; r < 17; ++r) acc[r] = 0.f;
        const GAS float* wp = P.w_ada + ((size_t)l * 1024 + wave * 128) * 6144 + n0 + lane;
#pragma unroll 4
        for (int kk = 0; kk < 128; ++kk) { const float w = __builtin_nontemporal_load(wp + (size_t)kk * 6144);
#pragma unroll
            for (int r = 0; r < 17; ++r) acc[r] += S[r * 1024 + wave * 128 + kk] * w; }
#pragma unroll
        for (int r = 0; r < 17; ++r) RED[(wave * 17 + r) * 64 + lane] = acc[r];
        __syncthreads();
        for (int idx = tid; idx < 17 * 64; idx += NTHREADS) { const int r = idx >> 6, ln = idx & 63; float s = P.b_ada[l * 6144 + n0 + ln];
#pragma unroll
            for (int w = 0; w < 8; ++w) s += RED[(w * 17 + r) * 64 + ln];
            MOD[(size_t)(l * 17 + r) * 6144 + n0 + ln] = s; }
        __syncthreads();
    }
}
__device__ __forceinline__ const GAS float* modp(const Ptrs& P, int l, int r, int j) { return (const GAS float*)(P.ws + WS_MOD) + ((size_t)(l * 17 + r) * 6 + j) * 1024; }

__device__ __forceinline__ void row_op(const GAS float* xsrc, GAS float* xdst, const GAS bf16_t* y, const GAS float* gate, const GAS float* gpost,
                                       const GAS float* gpre, const GAS float* mscale, const GAS float* mshift, GAS bf16_t* h0, GAS bf16_t* h1, int lane) {
    f32x4 v[4];
#pragma unroll
    for (int j = 0; j < 4; ++j) v[j] = *((const GAS f32x4*)xsrc + lane + 64 * j);
    if (y) {
        f32x4 yy[4]; float ss = 0.f;
#pragma unroll
        for (int j = 0; j < 4; ++j) { const u32x2 w = *((const GAS u32x2*)y + lane + 64 * j); yy[j] = (f32x4){bflo(w.x), bfhi(w.x), bflo(w.y), bfhi(w.y)};
            ss += (yy[j][0] * yy[j][0] + yy[j][1] * yy[j][1]) + (yy[j][2] * yy[j][2] + yy[j][3] * yy[j][3]); }
        const float r = __builtin_amdgcn_rsqf(wave_sum(ss) * (1.0f / 1024.0f) + EPS);
#pragma unroll
        for (int j = 0; j < 4; ++j) { const f32x4 gt = *((const GAS f32x4*)gate + lane + 64 * j), gp = *((const GAS f32x4*)gpost + lane + 64 * j); v[j] = v[j] + gt * (yy[j] * r * gp); }
        if (xdst) {
#pragma unroll
            for (int j = 0; j < 4; ++j) *((GAS f32x4*)xdst + lane + 64 * j) = v[j]; }
    }
    if (h0) {
        float s2 = 0.f;
#pragma unroll
        for (int j = 0; j < 4; ++j) s2 += (v[j][0] * v[j][0] + v[j][1] * v[j][1]) + (v[j][2] * v[j][2] + v[j][3] * v[j][3]);
        const float r2 = __builtin_amdgcn_rsqf(wave_sum(s2) * (1.0f / 1024.0f) + EPS);
#pragma unroll
        for (int j = 0; j < 4; ++j) { const f32x4 gp = *((const GAS f32x4*)gpre + lane + 64 * j), sc = *((const GAS f32x4*)mscale + lane + 64 * j), sh = *((const GAS f32x4*)mshift + lane + 64 * j);
            const f32x4 hv = (v[j] * r2 * gp) * (sc + 1.0f) + sh;
            u32x2 w; w.x = pk2(hv[0], hv[1]); w.y = pk2(hv[2], hv[3]);
            *((GAS u32x2*)h0 + lane + 64 * j) = w; if (h1) *((GAS u32x2*)h1 + lane + 64 * j) = w; }
    }
}
template <int NR, bool HASY, bool HASH>
__device__ __forceinline__ void row_block(const GAS float* xsrc, GAS float* xdst, const GAS bf16_t* y, GAS bf16_t* h, const f32x4 (&A1)[4], const f32x4 (&A2)[4], const f32x4 (&A3)[4], int lane) {
    f32x4 v[NR][4]; f32x4 yy[NR][4]; float ss[NR];
#pragma unroll
    for (int q = 0; q < NR; ++q)
#pragma unroll
        for (int j = 0; j < 4; ++j) v[q][j] = __builtin_nontemporal_load((const GAS f32x4*)(xsrc + (size_t)q * D) + lane + 64 * j);
    if (HASY) {
#pragma unroll
        for (int q = 0; q < NR; ++q) { ss[q] = 0.f;
#pragma unroll
            for (int j = 0; j < 4; ++j) { const u32x2 w = __builtin_nontemporal_load((const GAS u32x2*)(y + (size_t)q * D) + lane + 64 * j); yy[q][j] = (f32x4){bflo(w.x), bfhi(w.x), bflo(w.y), bfhi(w.y)};
                ss[q] += (yy[q][j][0] * yy[q][j][0] + yy[q][j][1] * yy[q][j][1]) + (yy[q][j][2] * yy[q][j][2] + yy[q][j][3] * yy[q][j][3]); } }
#pragma unroll
        for (int o = 1; o < 64; o <<= 1) {
#pragma unroll
            for (int q = 0; q < NR; ++q) ss[q] += __shfl_xor(ss[q], o); }
#pragma unroll
        for (int q = 0; q < NR; ++q) { const float r = __builtin_amdgcn_rsqf(ss[q] * (1.0f / 1024.0f) + EPS);
#pragma unroll
            for (int j = 0; j < 4; ++j) { v[q][j] = v[q][j] + A1[j] * (yy[q][j] * r); __builtin_nontemporal_store(v[q][j], (GAS f32x4*)(xdst + (size_t)q * D) + lane + 64 * j); } }
    }
    if (HASH) {
        float s2[NR];
#pragma unroll
        for (int q = 0; q < NR; ++q) { s2[q] = 0.f;
#pragma unroll
            for (int j = 0; j < 4; ++j) s2[q] += (v[q][j][0] * v[q][j][0] + v[q][j][1] * v[q][j][1]) + (v[q][j][2] * v[q][j][2] + v[q][j][3] * v[q][j][3]); }
#pragma unroll
        for (int o = 1; o < 64; o <<= 1) {
#pragma unroll
            for (int q = 0; q < NR; ++q) s2[q] += __shfl_xor(s2[q], o); }
#pragma unroll
        for (int q = 0; q < NR; ++q) { const float r2 = __builtin_amdgcn_rsqf(s2[q] * (1.0f / 1024.0f) + EPS);
#pragma unroll
            for (int j = 0; j < 4; ++j) { const f32x4 hv = (v[q][j] * r2) * A2[j] + A3[j]; u32x2 w; w.x = pg8::cvt_pk_bf16(hv[0], hv[1]); w.y = pg8::cvt_pk_bf16(hv[2], hv[3]); *((GAS u32x2*)(h + (size_t)q * D) + lane + 64 * j) = w; } }
    }
}
__device__ __forceinline__ void rowop_phase(const Ptrs& P, int kind, int g, int l) {
    const int lane = tid_opaque() & 63, wave = __builtin_amdgcn_readfirstlane(tid_opaque() >> 6);
    const int gw = blockIdx.x * 8 + wave, NGW = gridDim.x * 8;
    GAS bf16_t* H = (GAS bf16_t*)(P.ws + WS_H); const GAS bf16_t* Y = (const GAS bf16_t*)(P.ws + WS_OF); GAS float* XC = (GAS float*)(P.ws + WS_XC);
    for (int blk = gw; blk < RL / 16; blk += NGW) {
        const int rl = blk * 16, b = g * GB + (rl >> 12); const size_t xrow = (size_t)(b * SEQ + (rl & 4095)) * D; const int r = RC + rl;
        const GAS float*pg = nullptr, *pp = nullptr, *pq, *psc, *psh;
        if (kind == 0) { pq = P.g_pre_mix + l * D; psc = modp(P, l, b, 1); psh = modp(P, l, b, 0); }
        else if (kind == 1) { pg = modp(P, l, b, 2); pp = P.g_post_mix + l * D; pq = P.g_pre_ffn + l * D; psc = modp(P, l, b, 4); psh = modp(P, l, b, 3); }
        else { const int ln = l < 3 ? l + 1 : l; pg = modp(P, l, b, 5); pp = P.g_post_ffn + l * D; pq = P.g_pre_mix + ln * D; psc = modp(P, ln, b, 1); psh = modp(P, ln, b, 0); }
        f32x4 A1[4], A2[4], A3[4];
#pragma unroll
        for (int j = 0; j < 4; ++j) { A1[j] = (kind == 0) ? (f32x4){0.f, 0.f, 0.f, 0.f} : *((const GAS f32x4*)pg + lane + 64 * j) * *((const GAS f32x4*)pp + lane + 64 * j);
            A2[j] = *((const GAS f32x4*)pq + lane + 64 * j) * (*((const GAS f32x4*)psc + lane + 64 * j) + 1.0f); A3[j] = *((const GAS f32x4*)psh + lane + 64 * j); }
        if (kind == 0) { for (int i = 0; i < 16; i += 2) row_block<2, false, true>(P.x + xrow + (size_t)i * D, nullptr, nullptr, H + (size_t)(r + i) * D, A1, A2, A3, lane); }
        else if (kind == 1) { const GAS float* xs = (l == 0 ? P.x : P.out) + xrow; for (int i = 0; i < 16; i += 2) row_block<2, true, true>(xs + (size_t)i * D, P.out + xrow + (size_t)i * D, Y + (size_t)(r + i) * D, H + (size_t)(RCX + rl + i) * D, A1, A2, A3, lane); }
        else if (l < 3) { for (int i = 0; i < 16; i += 2) row_block<2, true, true>(P.out + xrow + (size_t)i * D, P.out + xrow + (size_t)i * D, Y + (size_t)(r + i) * D, H + (size_t)(r + i) * D, A1, A2, A3, lane); }
        else { for (int i = 0; i < 16; i += 2) row_block<2, true, false>(P.out + xrow + (size_t)i * D, P.out + xrow + (size_t)i * D, Y + (size_t)(r + i) * D, nullptr, A1, A2, A3, lane); }
    }
    if (kind != 0 && l == 3) return;
    for (int r = gw; r < RC; r += NGW) {
        const int bl = r >> 8, tc = r & 255, b = g * GB + bl, mr = 16; const size_t xrow = (size_t)(b * CTX + tc) * D;
        if (kind == 0) {
            row_op(P.ctx + xrow, nullptr, nullptr, nullptr, nullptr, P.g_pre_mix + l * D, modp(P, l, mr, 1), modp(P, l, mr, 0), H + (size_t)r * D, nullptr, lane);
        } else if (kind == 1) {
            const GAS float* xs = (l == 0 ? P.ctx : XC) + xrow; GAS float* xd = XC + xrow;
            GAS bf16_t*h0, *h1 = nullptr;
            const int gi = tc / 62, rr = tc - gi * 62 + 1; GAS bf16_t* hb = H + (size_t)(bl * 320) * D;
            h0 = hb + (size_t)(gi * 64 + rr) * D;
            if (rr == 62 && gi < 4) h1 = hb + (size_t)((gi + 1) * 64) * D;
            else if (rr == 1 && gi > 0) h1 = hb + (size_t)((gi - 1) * 64 + 63) * D;
            if (tc == 0) { u32x2 zz; zz.x = 0u; zz.y = 0u;
#pragma unroll
                for (int j = 0; j < 4; ++j) *((GAS u32x2*)hb + lane + 64 * j) = zz; }
            if (tc == 255) { u32x2 zz; zz.x = 0u; zz.y = 0u;
                for (int q = 9; q < 64; ++q) {
#pragma unroll
                    for (int j = 0; j < 4; ++j) *((GAS u32x2*)(hb + (size_t)(4 * 64 + q) * D) + lane + 64 * j) = zz; } }
            row_op(xs, xd, Y + (size_t)r * D, modp(P, l, mr, 2), P.g_post_mix + l * D, P.g_pre_ffn + l * D, modp(P, l, mr, 4), modp(P, l, mr, 3), h0, h1, lane);
        } else {
            GAS float* xd = XC + xrow;
            const bool nh = l < 3; const int ln = nh ? l + 1 : l;
            row_op(xd, xd, Y + (size_t)r * D, modp(P, l, mr, 5), P.g_post_ffn + l * D, P.g_pre_mix + ln * D, modp(P, ln, mr, 1), modp(P, ln, mr, 0), nh ? H + (size_t)r * D : nullptr, nullptr, lane);
        }
    }
}
__device__ __forceinline__ void hgout_phase(const Ptrs& P, int l, int skip) {
    const int lane = tid_opaque() & 63, wave = __builtin_amdgcn_readfirstlane(tid_opaque() >> 6);
    if ((int)blockIdx.x < skip) return;
    const int gw = ((int)blockIdx.x - skip) * 8 + wave, NGW = ((int)gridDim.x - skip) * 8;
    GAS bf16_t* OF = (GAS bf16_t*)(P.ws + WS_OF); const GAS bf16_t* OB = (const GAS bf16_t*)(P.ws + WS_OB); const GAS bf16_t* Z = (const GAS bf16_t*)(P.ws + WS_Z);
    const GAS float* gain = P.hg_out_norm + l * D + 16 * lane;
    float gn[16];
#pragma unroll
    for (int q = 0; q < 4; ++q) { const f32x4 t = *((const GAS f32x4*)gain + q); gn[4 * q] = t[0]; gn[4 * q + 1] = t[1]; gn[4 * q + 2] = t[2]; gn[4 * q + 3] = t[3]; }
    for (int r = (l == 3 ? RC : 0) + gw; r < MG; r += NGW) {
        const GAS u32x4* pf = (const GAS u32x4*)(OF + (size_t)r * D + 16 * lane); const GAS u32x4* pb = (const GAS u32x4*)(OB + (size_t)r * D + 16 * lane);
        const GAS u32x4* pg = (const GAS u32x4*)(Z + (size_t)r * INW + O_HG + 4 * 1024 + 16 * lane);
        float o[16], gv[16]; float ss = 0.f;
#pragma unroll
        for (int q = 0; q < 2; ++q) { const u32x4 a = pf[q], b = pb[q], c = pg[q];
            const unsigned aw[4] = {a.x, a.y, a.z, a.w}, bw[4] = {b.x, b.y, b.z, b.w}, cw4[4] = {c.x, c.y, c.z, c.w};
#pragma unroll
            for (int e = 0; e < 4; ++e) { const int i = 8 * q + 2 * e; o[i] = bflo(aw[e]) + bflo(bw[e]); o[i + 1] = bfhi(aw[e]) + bfhi(bw[e]); gv[i] = bflo(cw4[e]); gv[i + 1] = bfhi(cw4[e]); ss += o[i] * o[i] + o[i + 1] * o[i + 1]; } }
        ss += __shfl_xor(ss, 1); ss += __shfl_xor(ss, 2); ss += __shfl_xor(ss, 4);
        const float rr = __builtin_amdgcn_rsqf(ss * (1.0f / 128.0f) + EPS);
        u32x4 w[2];
#pragma unroll
        for (int q = 0; q < 2; ++q) { unsigned pw[4];
#pragma unroll
            for (int e = 0; e < 4; ++e) { const int i = 8 * q + 2 * e; const float y0 = o[i] * rr * gn[i] * (gv[i] * sigm(gv[i])), y1 = o[i + 1] * rr * gn[i + 1] * (gv[i + 1] * sigm(gv[i + 1])); pw[e] = pk2(y0, y1); }
            w[q].x = pw[0]; w[q].y = pw[1]; w[q].z = pw[2]; w[q].w = pw[3]; }
        GAS u32x4* po = (GAS u32x4*)(OF + (size_t)r * D + 16 * lane); po[0] = w[0]; po[1] = w[1];
    }
}
constexpr int HB_QI = 0, HB_KD = 8704, HB_KT = 17408, HB_VT = 27648, HB_E = 32768, HB_SZ = 33280;
constexpr int H_ST = 2 * HB_SZ, H_AM = H_ST + 64 * 272, H_TOT = H_AM + 32 * 80, H_END = H_TOT + 4096;
static_assert(H_END <= 131072, "hg lds");
__device__ __forceinline__ void hg_unit(const Ptrs& P, lptr lds, int l, int u) {
    const int tid = tid_opaque(), lane = tid & 63, wave = __builtin_amdgcn_readfirstlane(tid >> 6), l31 = lane & 31, hh = lane >> 5;
    const int bl = u >> 5, head = (u >> 2) & 7, dir = (u >> 1) & 1, vh = u & 1;
    const GAS bf16_t* Z = (const GAS bf16_t*)(P.ws + WS_Z);
    GAS bf16_t* O = (GAS bf16_t*)(P.ws + (dir ? WS_OB : WS_OF));
    const int kp = tid & 63, tg = tid >> 6;
    const GAS bf16_t* zq = Z + O_HG + head * 128 + 2 * kp;
    const GAS bf16_t* zf = Z + O_HG + (1 + dir) * 1024 + head * 128 + 2 * kp;
    const GAS bf16_t* zv = Z + O_HG + 3 * 1024 + head * 128 + vh * 64 + kp;
    GAS bf16_t* obase = O + head * 128 + vh * 64 + l31;
    for (int i = tid; i < 64 * 272 / 4; i += NTHREADS) *(LAS unsigned*)(lds + H_ST + 4 * i) = 0u;
    f32x16 Sacc;
#pragma unroll
    for (int i = 0; i < 16; ++i) Sacc[i] = 0.f;
    unsigned rq[4], rf[4]; unsigned short rv[4], cv[4];
    f32x2 bc[4], qv[4], kk[4];
#define HG_ROWS(j, rb, rs) long rb, rs; { const int _j = (j); if (_j < 8) { rs = dir ? -1 : 1; rb = (long)bl * CTX + (dir ? 255 - 32 * _j : 32 * _j); } \
        else { const int _m = _j - 8; const int _q0 = dir ? 4095 - 32 * _m : 32 * _m; rs = dir ? -64 : 64; rb = (long)RC + (long)bl * SEQ + (_q0 & 63) * 64 + (_q0 >> 6); } }
#define HG_LOAD(j) do { HG_ROWS(j, _rb, _rs); const long _o0 = (_rb + 4 * tg * _rs) * INW, _st = _rs * INW; \
        _Pragma("unroll") for (int i = 0; i < 4; ++i) { rq[i] = *(const GAS unsigned*)(zq + _o0 + i * _st); rf[i] = *(const GAS unsigned*)(zf + _o0 + i * _st); rv[i] = zv[_o0 + i * _st]; } } while (0)
#define HG_FEAT() do { f32x2 cum; cum.x = 0.f; cum.y = 0.f; _Pragma("unroll") for (int i = 0; i < 4; ++i) { qv[i].x = bflo(rq[i]); qv[i].y = bfhi(rq[i]); \
            f32x2 lf; lf.x = (float)__builtin_bit_cast(_Float16, (unsigned short)(rf[i] & 0xffffu)); lf.y = (float)__builtin_bit_cast(_Float16, (unsigned short)(rf[i] >> 16)); \
            f32x2 ef; ef.x = __builtin_amdgcn_exp2f(lf.x); ef.y = __builtin_amdgcn_exp2f(lf.y); kk[i] = 1.0f - ef; cum = cum + lf; bc[i] = cum; cv[i] = rv[i]; } \
        *(LAS f32x2*)(lds + H_TOT + (tg * 128 + 2 * kp) * 4) = cum; } while (0)
#define HG_WRITE(pb) do { \
        f32x2 off, blt; off.x = 0.f; off.y = 0.f; blt.x = 0.f; blt.y = 0.f; \
        _Pragma("unroll") for (int g2 = 0; g2 < 8; ++g2) { const f32x2 t = *(LAS f32x2*)(lds + H_TOT + (g2 * 128 + 2 * kp) * 4); if (g2 < tg) off = off + t; blt = blt + t; } \
        f32x2 kd[4]; \
        _Pragma("unroll") for (int i = 0; i < 4; ++i) { const int t = 4 * tg + i; const f32x2 b = bc[i] + off; \
            f32x2 e1, e2; e1.x = __builtin_amdgcn_exp2f(b.x); e1.y = __builtin_amdgcn_exp2f(b.y); e2.x = __builtin_amdgcn_exp2f(fminf(-b.x, 100.f)); e2.y = __builtin_amdgcn_exp2f(fminf(-b.y, 100.f)); \
            const f32x2 qi = qv[i] * e1; kd[i] = kk[i] * e2; \
            *(LAS unsigned*)(lds + (pb) + HB_QI + t * 272 + kp * 4) = pg8::cvt_pk_bf16(qi.x, qi.y); \
            *(LAS unsigned*)(lds + (pb) + HB_KD + t * 272 + kp * 4) = pg8::cvt_pk_bf16(kd[i].x, kd[i].y); } \
        { u32x2 w; w.x = pg8::cvt_pk_bf16(kd[0].x, kd[1].x); w.y = pg8::cvt_pk_bf16(kd[2].x, kd[3].x); *(LAS u32x2*)(lds + (pb) + HB_KT + (2 * kp) * 80 + tg * 8) = w; \
          w.x = pg8::cvt_pk_bf16(kd[0].y, kd[1].y); w.y = pg8::cvt_pk_bf16(kd[2].y, kd[3].y); *(LAS u32x2*)(lds + (pb) + HB_KT + (2 * kp + 1) * 80 + tg * 8) = w; } \
        if (tg == 0) { f32x2 e2; e2.x = __builtin_amdgcn_exp2f(blt.x); e2.y = __builtin_amdgcn_exp2f(blt.y); *(LAS f32x2*)(lds + (pb) + HB_E + (2 * kp) * 4) = e2; } \
        { u32x2 w; w.x = (unsigned)cv[0] | ((unsigned)cv[1] << 16); w.y = (unsigned)cv[2] | ((unsigned)cv[3] << 16); *(LAS u32x2*)(lds + (pb) + HB_VT + kp * 80 + tg * 8) = w; } } while (0)
    HG_LOAD(0); HG_FEAT(); HG_LOAD(1);
    LBAR();
    HG_WRITE(0);
    LBAR();
    for (int j = 0; j < 136; ++j) {
        const int pb = (j & 1) * HB_SZ;
        f32x16 o0, o1;
#pragma unroll
        for (int i = 0; i < 16; ++i) { o0[i] = 0.f; o1[i] = 0.f; }
        if (wave == 0) {
#pragma unroll
            for (int ks = 0; ks < 8; ks += 2) {
                const bf16x8 a = *(const LAS bf16x8*)(lds + pb + HB_KD + l31 * 272 + 32 * ks + 16 * hh), b = *(const LAS bf16x8*)(lds + pb + HB_QI + l31 * 272 + 32 * ks + 16 * hh);
                const bf16x8 a2 = *(const LAS bf16x8*)(lds + pb + HB_KD + l31 * 272 + 32 * (ks + 1) + 16 * hh), b2 = *(const LAS bf16x8*)(lds + pb + HB_QI + l31 * 272 + 32 * (ks + 1) + 16 * hh);
                o0 = MFMA32(a, b, o0); o1 = MFMA32(a2, b2, o1); }
        } else if (wave <= 2) {
            const int vi = wave - 1;
#pragma unroll
            for (int ks = 0; ks < 8; ks += 2) {
                const bf16x8 a = *(const LAS bf16x8*)(lds + pb + HB_QI + l31 * 272 + 32 * ks + 16 * hh), b = *(const LAS bf16x8*)(lds + H_ST + (32 * vi + l31) * 272 + 32 * ks + 16 * hh);
                const bf16x8 a2 = *(const LAS bf16x8*)(lds + pb + HB_QI + l31 * 272 + 32 * (ks + 1) + 16 * hh), b2 = *(const LAS bf16x8*)(lds + H_ST + (32 * vi + l31) * 272 + 32 * (ks + 1) + 16 * hh);
                o0 = MFMA32(a, b, o0); o1 = MFMA32(a2, b2, o1); }
        }
        { HG_FEAT(); const int jn = (j + 2 < 136) ? j + 2 : 135; HG_LOAD(jn); }
        if (wave == 0) {
#pragma unroll
            for (int gq = 0; gq < 4; ++gq) { const int s0 = 8 * gq + 4 * hh; float m[4];
#pragma unroll
                for (int e = 0; e < 4; ++e) m[e] = (s0 + e <= l31) ? (o0[4 * gq + e] + o1[4 * gq + e]) : 0.f;
                u32x2 w; w.x = pg8::cvt_pk_bf16(m[0], m[1]); w.y = pg8::cvt_pk_bf16(m[2], m[3]); *(LAS u32x2*)(lds + H_AM + l31 * 80 + s0 * 2) = w; }
        }
        LBAR();
        if (wave == 1 || wave == 2) {
            const int vi = wave - 1;
            { const bf16x8 a = *(const LAS bf16x8*)(lds + H_AM + l31 * 80 + 16 * hh), b = *(const LAS bf16x8*)(lds + pb + HB_VT + (32 * vi + l31) * 80 + 16 * hh); o0 = MFMA32(a, b, o0); }
            { const bf16x8 a = *(const LAS bf16x8*)(lds + H_AM + l31 * 80 + 32 + 16 * hh), b = *(const LAS bf16x8*)(lds + pb + HB_VT + (32 * vi + l31) * 80 + 32 + 16 * hh); o1 = MFMA32(a, b, o1); }
            HG_ROWS(j, rb, rs);
            GAS bf16_t* op = obase + 32 * vi + (rb + 4 * hh * rs) * D; const long ost = rs * D;
#pragma unroll
            for (int r = 0; r < 16; r += 2) { const int t = (r & 3) + 8 * (r >> 2); const unsigned w = pg8::cvt_pk_bf16(o0[r] + o1[r], o0[r + 1] + o1[r + 1]); op[t * ost] = (bf16_t)(w & 0xffffu); op[(t + 1) * ost] = (bf16_t)(w >> 16); }
        }
        { const int ki = wave & 3, vi2 = wave >> 2;
#pragma unroll
          for (int ks = 0; ks < 2; ++ks) { const bf16x8 a = *(const LAS bf16x8*)(lds + pb + HB_KT + (32 * ki + l31) * 80 + 32 * ks + 16 * hh), b = *(const LAS bf16x8*)(lds + pb + HB_VT + (32 * vi2 + l31) * 80 + 32 * ks + 16 * hh); Sacc = MFMA32(a, b, Sacc); }
#pragma unroll
          for (int gq = 0; gq < 4; ++gq) { const f32x4 e4 = *(const LAS f32x4*)(lds + pb + HB_E + (32 * ki + 8 * gq + 4 * hh) * 4);
#pragma unroll
              for (int e = 0; e < 4; ++e) Sacc[4 * gq + e] *= e4[e];
              u32x2 w; w.x = pg8::cvt_pk_bf16(Sacc[4 * gq], Sacc[4 * gq + 1]); w.y = pg8::cvt_pk_bf16(Sacc[4 * gq + 2], Sacc[4 * gq + 3]);
              *(LAS u32x2*)(lds + H_ST + (32 * vi2 + l31) * 272 + (32 * ki + 8 * gq + 4 * hh) * 2) = w; } }
        { const int pn = ((j + 1) & 1) * HB_SZ; HG_WRITE(pn); }
        LBAR();
    }
#undef HG_LOAD
#undef HG_FEAT
#undef HG_WRITE
#undef HG_ROWS
}

constexpr int RXB = 0, RXF = RXB + 128 * 144, RAA = RXF + 128 * 128, RBB = RAA + 128 * 128, RCAR = RBB + 128 * 128, RCARRY = RCAR + 16 * 32 * 8, REND = RCARRY + 256;
typedef float f32x4v __attribute__((ext_vector_type(4)));
#define MFMA16(a, b, c) __builtin_amdgcn_mfma_f32_16x16x32_bf16((a), (b), (c), 0, 0, 0)
__device__ __forceinline__ void rg_unit(const Ptrs& P, lptr lds, int l, int u) {
    const int tid = tid_opaque(), lane = tid & 63, wave = __builtin_amdgcn_readfirstlane(tid >> 6), l15 = lane & 15, q4 = lane >> 4;
    const int bl = u >> 5, head = (u >> 1) & 15, hf = u & 1;
    const int c0 = head * 64;
    const GAS bf16_t* Z = (const GAS bf16_t*)(P.ws + WS_Z);
    GAS bf16_t* R0 = (GAS bf16_t*)(P.ws + WS_R0);
    const int cp = tid & 31, tg = tid >> 5;
    float cwv[2][4], cbv[2];
#pragma unroll
    for (int e = 0; e < 2; ++e) { cbv[e] = P.rg_conv_b[l * 1024 + c0 + 2 * cp + e];
#pragma unroll
        for (int jj = 0; jj < 4; ++jj) cwv[e][jj] = P.rg_conv_w[(l * 4 + jj) * 1024 + c0 + 2 * cp + e]; }
    const int sc = tid & 31, sub = tid >> 5;
    const int mych = c0 + 32 * hf + sc;
    const GAS bf16_t* zx = Z + O_RGX + c0 + 2 * cp;
    const GAS bf16_t* zg = Z + O_RGG + mych;
    GAS bf16_t* rp = R0 + mych;
#pragma unroll
    for (int d = 0; d < 2; ++d) {
        bf16x8 wfa[2][2], wfx[2][2]; float c8l[2], bal[2], bxl[2];
#pragma unroll
        for (int nt = 0; nt < 2; ++nt) {
            const size_t wb = ((size_t)((l * 2 + d) * 16 + head) * 64) * 64 + 32 * hf + 16 * nt + l15;
            float fa[2][8], fx[2][8];
#pragma unroll
            for (int ks = 0; ks < 2; ++ks)
#pragma unroll
                for (int e = 0; e < 8; ++e) { const int i0 = 32 * ks + 8 * q4 + e; fa[ks][e] = P.rg_wa[wb + (size_t)i0 * 64]; fx[ks][e] = P.rg_wx[wb + (size_t)i0 * 64]; }
#pragma unroll
            for (int ks = 0; ks < 2; ++ks) { u32x4 t;
                t.x = pk2(fa[ks][0], fa[ks][1]); t.y = pk2(fa[ks][2], fa[ks][3]); t.z = pk2(fa[ks][4], fa[ks][5]); t.w = pk2(fa[ks][6], fa[ks][7]); wfa[nt][ks] = __builtin_bit_cast(bf16x8, t);
                t.x = pk2(fx[ks][0], fx[ks][1]); t.y = pk2(fx[ks][2], fx[ks][3]); t.z = pk2(fx[ks][4], fx[ks][5]); t.w = pk2(fx[ks][6], fx[ks][7]); wfx[nt][ks] = __builtin_bit_cast(bf16x8, t); }
            const int gch = (l * 2 + d) * 1024 + c0 + 32 * hf + 16 * nt + l15;
            c8l[nt] = 8.0f * 1.4426950408889634f * log1pf(expf(-P.rg_lam[gch]));
            bal[nt] = P.rg_ba[gch]; bxl[nt] = P.rg_bx[gch];
        }
#define RG_TILE(n, t0, rbase, len) int t0, len; long rbase; { const int _n = (n); if (_n < 2) { t0 = 128 * (d ? 1 - _n : _n); len = CTX; rbase = (long)bl * CTX; } else { t0 = 128 * (d ? 33 - _n : _n - 2); len = SEQ; rbase = (long)RC + (long)bl * SEQ; } }
        unsigned zr[11]; unsigned zvalid = 0u;
#define RG_LOAD(n) do { RG_TILE(n, _t0, _rb, _len); const int _ts = _t0 + 8 * tg - 1; const GAS bf16_t* _p = zx + (_rb + _ts) * INW; \
        _Pragma("unroll") for (int i = 0; i < 11; ++i) { const int _t = _ts + i; const int _tc = _t < 0 ? 0 : (_t >= _len ? _len - 1 : _t); zr[i] = *(const GAS unsigned*)(_p + (long)(_tc - _ts) * INW); } \
        zvalid = 0u; _Pragma("unroll") for (int i = 0; i < 11; ++i) { const int _t = _ts + i; if (_t >= 0 && _t < _len) zvalid |= (1u << i); } } while (0)
#define RG_CONV() do { _Pragma("unroll") for (int i = 0; i < 11; ++i) zr[i] = ((zvalid >> i) & 1u) ? zr[i] : 0u; \
        _Pragma("unroll") for (int i = 0; i < 8; ++i) { \
            const float x0 = cbv[0] + cwv[0][0] * bflo(zr[i]) + cwv[0][1] * bflo(zr[i + 1]) + cwv[0][2] * bflo(zr[i + 2]) + cwv[0][3] * bflo(zr[i + 3]); \
            const float x1 = cbv[1] + cwv[1][0] * bfhi(zr[i]) + cwv[1][1] * bfhi(zr[i + 1]) + cwv[1][2] * bfhi(zr[i + 2]) + cwv[1][3] * bfhi(zr[i + 3]); \
            const int tt = 8 * tg + i; *(LAS unsigned*)(lds + RXB + tt * 144 + cp * 4) = pg8::cvt_pk_bf16(x0, x1); \
            if ((cp >> 4) == hf) { f32x2 xx; xx.x = x0; xx.y = x1; *(LAS f32x2*)(lds + RXF + tt * 128 + (cp & 15) * 8) = xx; } } } while (0)
#define RG_GATES() do { f32x4v ga[2], gx[2]; _Pragma("unroll") for (int nt = 0; nt < 2; ++nt) { ga[nt] = (f32x4v){0.f, 0.f, 0.f, 0.f}; gx[nt] = (f32x4v){0.f, 0.f, 0.f, 0.f}; } \
        _Pragma("unroll") for (int ks = 0; ks < 2; ++ks) { const bf16x8 af = *(const LAS bf16x8*)(lds + RXB + (16 * wave + l15) * 144 + 64 * ks + 16 * q4); \
            _Pragma("unroll") for (int nt = 0; nt < 2; ++nt) { ga[nt] = MFMA16(af, wfa[nt][ks], ga[nt]); gx[nt] = MFMA16(af, wfx[nt][ks], gx[nt]); } } \
        _Pragma("unroll") for (int nt = 0; nt < 2; ++nt) _Pragma("unroll") for (int r = 0; r < 4; ++r) { const int tt = 16 * wave + 4 * q4 + r, cc = 16 * nt + l15; \
            const float xv = *(LAS float*)(lds + RXF + tt * 128 + cc * 4); \
            const float la = -c8l[nt] * sigm(ga[nt][r] + bal[nt]); const float av = __builtin_amdgcn_exp2f(la); \
            const float bv = __builtin_amdgcn_sqrtf(fmaxf(1.0f - av * av, 0.f)) * sigm(gx[nt][r] + bxl[nt]) * xv; \
            *(LAS float*)(lds + RAA + tt * 128 + cc * 4) = av; *(LAS float*)(lds + RBB + tt * 128 + cc * 4) = bv; } } while (0)
        LBAR();
        if (tid < 32) *(LAS float*)(lds + RCARRY + tid * 4) = 0.f;
        RG_LOAD(0); RG_CONV(); RG_LOAD(1);
        LBAR();
        RG_GATES();
        LBAR();
        for (int n = 0; n < 34; ++n) {
            RG_TILE(n, t0, rbase, len); (void)len;
            float av[8], bv[8]; float Pp = 1.f, Hl = 0.f;
#pragma unroll
            for (int ii = 0; ii < 8; ++ii) { const int i = d ? 7 - ii : ii; const int tt = 8 * sub + i;
                const float a = *(LAS float*)(lds + RAA + tt * 128 + sc * 4), b = *(LAS float*)(lds + RBB + tt * 128 + sc * 4);
                av[ii] = a; bv[ii] = b; Hl = a * Hl + b; Pp *= a; }
            { f32x2 ph; ph.x = Pp; ph.y = Hl; *(LAS f32x2*)(lds + RCAR + (sub * 32 + sc) * 8) = ph; }
            unsigned short gr[8], hr[8];
            if (d == 1) {
#pragma unroll
                for (int ii = 0; ii < 8; ++ii) { const long ro = rbase + t0 + 8 * sub + (7 - ii); gr[ii] = zg[ro * INW]; hr[ii] = rp[ro * D]; }
            }
            { RG_CONV(); const int nn = (n + 2 < 34) ? n + 2 : 33; RG_LOAD(nn); }
            LBAR();
            float hin = *(LAS float*)(lds + RCARRY + ((n & 1) * 32 + sc) * 4);
#pragma unroll
            for (int idx = 0; idx < 16; ++idx) { const int s2 = d ? 15 - idx : idx; const f32x2 ph = *(LAS f32x2*)(lds + RCAR + (s2 * 32 + sc) * 8);
                const bool use = d ? (s2 > sub) : (s2 < sub); hin = use ? ph.x * hin + ph.y : hin; }
            float outv[8];
#pragma unroll
            for (int ii = 0; ii < 8; ++ii) { hin = av[ii] * hin + bv[ii];
                if (d == 0) outv[ii] = hin;
                else { const float gg = bf1(gr[ii]); const float uu = 1.5957691216057308f * (gg + 0.044715f * gg * gg * gg);
                       outv[ii] = gg * sigm(uu) * (bf1(hr[ii]) + hin); } }
#pragma unroll
            for (int ii = 0; ii < 8; ii += 2) { const unsigned w = pg8::cvt_pk_bf16(outv[ii], outv[ii + 1]);
                const long ro0 = rbase + t0 + 8 * sub + (d ? 7 - ii : ii), ro1 = rbase + t0 + 8 * sub + (d ? 6 - ii : ii + 1);
                rp[ro0 * D] = (bf16_t)(w & 0xffffu); rp[ro1 * D] = (bf16_t)(w >> 16); }
            if ((d == 0 && sub == 15) || (d == 1 && sub == 0)) *(LAS float*)(lds + RCARRY + (((n + 1) & 1) * 32 + sc) * 4) = hin;
            { RG_GATES(); }
            LBAR();
        }
#undef RG_TILE
#undef RG_LOAD
#undef RG_CONV
#undef RG_GATES
    }
}

#define XB_TMO      128
#define XB_XCNT(j)  (256  + 64 * (j))
#define XB_XSUB(j)  (1280 + 64 * (j))
#define XB_XGEN(j)  (2304 + 64 * (j))
#define XB_TOP      3328
#define XB_TOPGEN   3392
#define XCD_BAR_WORDS 3456
#define XB_SPIN_CAP (1u << 18)

__device__ __forceinline__ unsigned xb_ld(unsigned* p)              { return __hip_atomic_load(p, __ATOMIC_RELAXED, __HIP_MEMORY_SCOPE_AGENT); }
__device__ __forceinline__ unsigned xb_add(unsigned* p, unsigned v) { return __hip_atomic_fetch_add(p, v, __ATOMIC_RELAXED, __HIP_MEMORY_SCOPE_AGENT); }
__device__ __forceinline__ unsigned xb_xcc_id() { return (unsigned)__builtin_amdgcn_s_getreg((3 << 11) | 20) & 0xFu; }
#define XB_SPIN(cond, bar) do { unsigned _sp = 0; while (cond) { __builtin_amdgcn_s_sleep(1); \
    if ((++_sp & 255u) == 0u) { if (xb_ld(&(bar)[XB_TMO])) break; if (_sp > XB_SPIN_CAP) { atomicAdd(&(bar)[XB_TMO], 1u); break; } } } } while (0)

struct XcdBarrier {
    unsigned* bar; unsigned x;
    volatile LAS unsigned* st;
};

__device__ __forceinline__ XcdBarrier xcd_barrier_post(unsigned* bar, volatile LAS unsigned* st) {
    XcdBarrier b; b.bar = bar; b.x = xb_xcc_id(); b.st = st;
    if (tid_opaque() == 0) (void)xb_add(&bar[XB_XCNT(b.x)], 1u);
    return b;
}
__device__ __forceinline__ void xcd_barrier_complete(unsigned* bar, unsigned x, unsigned& nloc, unsigned& nx) {
    const unsigned G = gridDim.x * gridDim.y * gridDim.z;
    unsigned sum, cnt, mine, sp = 0u;
    for (;;) {
        sum = 0u; cnt = 0u; mine = 0u;
#pragma unroll
        for (unsigned j = 0; j < 16; ++j) { const unsigned c = xb_ld(&bar[XB_XCNT(j)]); sum += c; cnt += (c > 0u) ? 1u : 0u; mine = (j == x) ? c : mine; }
        if (sum == G) break;
        __builtin_amdgcn_s_sleep(1);
        if ((++sp & 255u) == 0u) { if (xb_ld(&bar[XB_TMO])) break; if (sp > XB_SPIN_CAP) { atomicAdd(&bar[XB_TMO], 1u); break; } }
    }
    nloc = mine > 0u ? mine : 1u; nx = cnt > 0u ? cnt : 1u;
}

__device__ __forceinline__ void xcd_barrier(const XcdBarrier& b) {
    asm volatile("s_waitcnt vmcnt(0)" ::: "memory");
    __syncthreads();
    if (tid_opaque() == 0) {
        unsigned* bar = b.bar;
        __builtin_amdgcn_s_waitcnt(0);
        unsigned nloc = b.st[0], nx = b.st[1];
        if (nloc == 0u) { xcd_barrier_complete(bar, b.x, nloc, nx); b.st[0] = nloc; b.st[1] = nx; }
        const unsigned old = xb_add(&bar[XB_XSUB(b.x)], 1u);
        const unsigned gen = old / nloc;
        if (old + 1u == (gen + 1u) * nloc) {
            __builtin_amdgcn_fence(__ATOMIC_RELEASE, "agent");
            asm volatile("s_waitcnt vmcnt(0)" ::: "memory");
            const unsigned og = xb_add(&bar[XB_TOP], 1u);
            const unsigned tg = og / nx;
            if (og + 1u == (tg + 1u) * nx) xb_add(&bar[XB_TOPGEN], 1u);
            else XB_SPIN(xb_ld(&bar[XB_TOPGEN]) == tg, bar);
            __builtin_amdgcn_fence(__ATOMIC_ACQUIRE, "agent");
            xb_add(&bar[XB_XGEN(b.x)], 1u);
            asm volatile("s_waitcnt vmcnt(0)" ::: "memory");
        } else {
            XB_SPIN(xb_ld(&bar[XB_XGEN(b.x)]) == gen, bar);
            __builtin_amdgcn_fence(__ATOMIC_ACQUIRE, "agent");
            asm volatile("s_waitcnt vmcnt(0)" ::: "memory");
        }
    }
    __syncthreads();
}

struct Args { Ptrs p; int lo, hi; };
__global__ void __launch_bounds__(NTHREADS, 2) mega_fwd(Args args) {
    extern __shared__ __attribute__((aligned(16))) unsigned char lds_raw[];
    cg::grid_group grid = cg::this_grid();
    lptr lds = (lptr)lds_raw;
    const int lo = args.lo, hi = args.hi;
    typedef const Args __attribute__((address_space(4)))* kargp_t;
#define KP() ({ kargp_t _p = (kargp_t)__builtin_amdgcn_kernarg_segment_ptr(); asm volatile("" : "+s"(_p)); _p; })
#define GETP() Ptrs P; { kargp_t _kp = KP(); const unsigned long long* _src = (const unsigned long long*)_kp; unsigned long long* _dst = (unsigned long long*)&P; _Pragma("unroll") for (int _i = 0; _i < 29; ++_i) _dst[_i] = _src[_i]; } GAS unsigned char* ws = P.ws;
    int ph = 0;
    { volatile LAS unsigned* st0 = (volatile LAS unsigned*)(lds + XB_LDS_OFF); if (tid_opaque() < 2) st0[tid_opaque()] = 0u; }
    __syncthreads();
    XcdBarrier xbar = xcd_barrier_post((unsigned*)args.p.ws, (volatile LAS unsigned*)(lds + XB_LDS_OFF));
#define RUN (ph >= lo && ph < hi)
#define SEAM() do { ++ph; if (ph > lo && ph < hi) { if (ph == 1) grid.sync(); else xcd_barrier(xbar); } } while (0)
#define BUFS() GAS bf16_t* H = (GAS bf16_t*)(ws + WS_H); GAS bf16_t* R0 = (GAS bf16_t*)(ws + WS_R0); GAS bf16_t* OF = (GAS bf16_t*)(ws + WS_OF); GAS bf16_t* OB = (GAS bf16_t*)(ws + WS_OB); GAS bf16_t* Z = (GAS bf16_t*)(ws + WS_Z); GAS bf16_t* ACT = Z; (void)H; (void)R0; (void)OF; (void)OB; (void)ACT;
    const int G = gridDim.x, bid = blockIdx.x;

    if (RUN) { GETP(); BUFS(); mods_phase(P, lds); __syncthreads(); convert_weights(P, lds, 0); }
    SEAM();
    if (RUN) { GETP(); BUFS(); rowop_phase(P, 0, 0, 0); }
    SEAM();
    for (int g = 0; g < NGRP; ++g) {
        for (int l = 0; l < DEPTH; ++l) {
            const bool last = (l == DEPTH - 1);
            const int roff = last ? RC : 0, Mm = last ? RL : MG;
            if (RUN) { GETP(); BUFS(); pg8::Gemm gm{(const bf16_t*)(H), (const bf16_t*)(ws + WS_WIN), MG, INW, D}; EpiZ E{Z, (const GAS float*)(ws + WS_LB) + l * 1024};
                if (last) { pg8::LastLayerOrder S; S.init(RL, INW, RC / 256, G, bid); pg8::gemm_phase<EpiZ, pg8::LastLayerOrder>(lds, gm, S, E); }
                else { pg8::StaticOrder S; S.init(MG, INW, G, bid); pg8::gemm_phase<EpiZ, pg8::StaticOrder>(lds, gm, S, E); } }
            SEAM();
            if (RUN) { GETP(); BUFS(); const int vb = (G % 8 == 0) ? (bid % 8) * (G / 8) + bid / 8 : bid;
                       for (int u = vb; u < 256; u += G) hg_unit(P, lds, l, u);
                       for (int u = vb; u < 256; u += G) rg_unit(P, lds, l, u); }
            SEAM();
            if (RUN) { GETP(); BUFS(); pg8::StaticOrder S; S.init(Mm, D, G, bid);
                { pg8::Gemm gm{(const bf16_t*)(R0 + (size_t)roff * D), (const bf16_t*)(ws + WS_WPRG), Mm, D, D}; EpiGate<0> E{Z + O_GA, nullptr, H, roff}; pg8::gemm_phase<EpiGate<0>, pg8::StaticOrder>(lds, gm, S, E); }
                const int nun = (Mm / 256) * (D / 256); const int extra = (nun % G != 0 && G > 64) ? (nun % G) : 0;
                hgout_phase(P, l, extra <= G / 2 ? extra : 0); }
            SEAM();
            if (RUN) { GETP(); BUFS(); pg8::StaticOrder S; S.init(Mm, D, G, bid);
                { pg8::Gemm gm{(const bf16_t*)(OF + (size_t)roff * D), (const bf16_t*)(ws + WS_WPHG), Mm, D, D}; EpiGate<1> E{Z + O_GB, H, OB, roff}; pg8::gemm_phase<EpiGate<1>, pg8::StaticOrder>(lds, gm, S, E); } }
            SEAM();
            if (RUN) { GETP(); BUFS(); pg8::Gemm gm{(const bf16_t*)(OB + (size_t)roff * D), (const bf16_t*)(ws + WS_WOUT), Mm, D, D}; pg8::StaticOrder S; S.init(Mm, D, G, bid); EpiStore E{OF, D, roff}; pg8::gemm_phase<EpiStore, pg8::StaticOrder>(lds, gm, S, E); }
            SEAM();
            if (RUN) { GETP(); BUFS(); rowop_phase(P, 1, g, l); }
            SEAM();
            if (RUN) { GETP(); BUFS(); const int xoff = last ? RCX : 0, Mu = last ? RL : MGX;
                pg8::Gemm gm{(const bf16_t*)(H + (size_t)xoff * D), (const bf16_t*)(ws + WS_WUP), Mu, NUP, D}; pg8::StaticOrder S; S.init(Mu, NUP, G, bid);
                EpiUp E{ACT, P.ffn_conv_w + (size_t)l * 3 * DFF, P.ffn_conv_b + (size_t)l * DFF, last ? 10 : 0}; pg8::gemm_phase<EpiUp, pg8::StaticOrder>(lds, gm, S, E); }
            SEAM();
            if (RUN) { GETP(); BUFS(); pg8::Gemm gm{(const bf16_t*)(ACT + (size_t)roff * DFF), (const bf16_t*)(ws + WS_WDN), Mm, D, DFF}; pg8::StaticOrder S; S.init(Mm, D, G, bid); EpiStore E{OF, D, roff}; pg8::gemm_phase<EpiStore, pg8::StaticOrder>(lds, gm, S, E);
                const int nun = (Mm / 256) * (D / 256); const int extra = (nun % G != 0 && G > 64 && (nun % G) <= G / 2) ? (nun % G) : 0;
                LBAR();
                if (!last) convert_weights(P, lds, l + 1, 1, extra); else if (g + 1 < NGRP) convert_weights(P, lds, 0, 1, extra); }
            SEAM();
            if (RUN) { GETP(); BUFS(); rowop_phase(P, 2, g, l);
                if (!last) convert_weights(P, lds, l + 1, 2);
                else if (g + 1 < NGRP) { convert_weights(P, lds, 0, 2); rowop_phase(P, 0, g + 1, 0); } }
            SEAM();
        }
    }
#undef RUN
#undef SEAM
}
constexpr int N_PHASES = 2 + NGRP * DEPTH * 9;

extern "C" void kernel_launch(void* const* d_in, const int* in_sizes, int n_in, void* d_out, int out_size, void* d_ws, size_t ws_size, hipStream_t stream) {
    static int grid = 0;
    if (grid == 0) {
        if (n_in != 27 || ws_size < WS_END) { fprintf(stderr, "kernel_launch: unexpected n_in %d or ws_size %zu (< %zu)\n", n_in, ws_size, (size_t)WS_END); grid = -1; return; }
        int dev = 0, cus = 0, per_cu = 0;
        (void)hipGetDevice(&dev);
        (void)hipDeviceGetAttribute(&cus, hipDeviceAttributeMultiprocessorCount, dev);
        if (hipFuncSetAttribute((const void*)mega_fwd, hipFuncAttributeMaxDynamicSharedMemorySize, LDS_BYTES) != hipSuccess) { fprintf(stderr, "kernel_launch: hipFuncSetAttribute failed\n"); grid = -1; return; }
        if (hipOccupancyMaxActiveBlocksPerMultiprocessor(&per_cu, (const void*)mega_fwd, NTHREADS, LDS_BYTES) != hipSuccess || per_cu < 1) { fprintf(stderr, "kernel_launch: occupancy query says %d\n", per_cu); per_cu = 1; }
        (void)hipGetLastError();
        grid = cus * 1;
        fprintf(stderr, "kernel_launch: cus %d per_cu %d grid %d\n", cus, per_cu, grid);
    }
    if (grid < 0) return;
    if (hipMemsetAsync(d_ws, 0, 65536, stream) != hipSuccess) { fprintf(stderr, "kernel_launch: memset failed\n"); return; }
    Args a{};
    const GAS float** pp = (const GAS float**)&a.p;
    for (int i = 0; i < 27; ++i) pp[i] = (const GAS float*)d_in[i];
    a.p.out = (GAS float*)d_out; a.p.ws = (GAS unsigned char*)d_ws;
#ifdef MULTI_LAUNCH
    for (int p = 0; p < N_PHASES; ++p) { a.lo = p; a.hi = p + 1; hipLaunchKernelGGL(mega_fwd, dim3(grid), dim3(NTHREADS), LDS_BYTES, stream, a); }
#else
    a.lo = 0; a.hi = N_PHASES;
    void* kargs[] = {&a};
    hipError_t e = hipLaunchCooperativeKernel((void*)mega_fwd, dim3(grid), dim3(NTHREADS), kargs, LDS_BYTES, stream);
    if (e != hipSuccess) fprintf(stderr, "cooperative launch failed: %s (grid %d)\n", hipGetErrorString(e), grid);
#endif
}
```

```cpp
#include <hip/hip_runtime.h>
#include <hip/hip_cooperative_groups.h>
#include <cstdio>
namespace cg = cooperative_groups;
__device__ __forceinline__ int tid_opaque() { int t = threadIdx.x; asm volatile("" : "+v"(t)); return t; }
namespace pg8 {
#define PG8_LAS __attribute__((address_space(3)))
typedef unsigned short bf16_t;
typedef short bf16x8 __attribute__((ext_vector_type(8)));
typedef float f32x4 __attribute__((ext_vector_type(4)));
typedef unsigned u32x4 __attribute__((ext_vector_type(4)));
constexpr int BM = 256, BK = 64, HALF = 128, HTB = HALF * BK * 2  , STAGE_BYTES = 8 * HTB, NXCD = 8, WGM = 8;

__host__ __device__ __forceinline__ int lds_byte(int r, int c) { const int st = (r >> 4) * 2 + (c >> 5), rr = r & 15, cc = c & 31, ob = rr * 64 + cc * 2; return st * 1024 + (ob ^ (((ob >> 9) & 1) << 5)); }
__host__ __device__ __forceinline__ void stage_rc(int b, int& R, int& C) { const int st = b / 1024, sb = b % 1024, swz = sb ^ (((sb >> 9) & 1) << 5); R = (st >> 1) * 16 + swz / 64; C = (st & 1) * 32 + (swz % 64) / 2; }
__host__ __device__ __forceinline__ int perm32(int rho) { const int n = rho >> 4, i = rho & 15; return 8 * (i >> 2) + 4 * n + (i & 3); }

struct Unit { int pm, pn; };
struct Gemm { const bf16_t* A; const bf16_t* Bt; int M, N, K; };

struct StaticOrder {
    int nM, nN, nwg, G, c;
    __host__ __device__ void init(int M, int N, int G_, int c_) { nM = M / BM; nN = N / BM; nwg = nM * nN; G = G_; c = c_; }
    __host__ __device__ bool next(int i, Unit& u) const {
        const long L = (long)i * G + c; if (L >= nwg) return false;
        int wgid = (int)L; { const int q = nwg / NXCD, r = nwg % NXCD, xcd = wgid % NXCD, off = wgid / NXCD; wgid = (xcd < r ? xcd * (q + 1) : r * (q + 1) + (xcd - r) * q) + off; }
        const int nig = WGM * nN, gid = wgid / nig, fm = gid * WGM, gsz = (nM - fm) < WGM ? (nM - fm) : WGM;
        u.pm = fm + ((wgid % nig) % gsz); u.pn = (wgid % nig) / gsz; return true;
    }
    __device__ __forceinline__ void a_ready(const Unit&) const {}
    __device__ __forceinline__ void done(const Unit&) const {}
};
struct LastLayerOrder {
    StaticOrder lat; int G, c, ct, nlat;
    __host__ __device__ void init(int Mlat, int N, int ctx_tiles, int G_, int c_) { lat.init(Mlat, N, G_, c_); G = G_; c = c_; ct = ctx_tiles; nlat = lat.nwg; }
    __host__ __device__ bool next(int i, Unit& u) const {
        const long L = (long)i * G + c;
        if (L < nlat) { lat.next(i, u); u.pm += ct; return true; }
        const int k = (int)(L - nlat); if (k >= ct * 20) return false;
        u.pm = k / 20; const int j = k % 20; u.pn = j < 4 ? j : j + 4; return true;
    }
    __device__ __forceinline__ void a_ready(const Unit&) const {}
    __device__ __forceinline__ void done(const Unit&) const {}
};
__device__ __forceinline__ unsigned cvt_pk_bf16(float lo, float hi) { unsigned r; asm volatile("v_cvt_pk_bf16_f32 %0, %1, %2" : "=v"(r) : "v"(lo), "v"(hi)); return r; }
template <class Epi, class Sched>
__device__ __forceinline__ void gemm_phase(PG8_LAS unsigned char* lds, const Gemm g, const Sched& S, const Epi& E) {
    const int tid = tid_opaque(), wid = __builtin_amdgcn_readfirstlane(tid >> 6), lane = tid & 63, wr = wid >> 2, wc = wid & 3, fr = lane & 15, fq = lane >> 4;
    const int K = g.K, nt = K / BK;
    unsigned voffA[2], voffB[2];
#pragma unroll
    for (int i = 0; i < 2; ++i) { int R, C; stage_rc(tid * 16 + i * 8192, R, C); const int Rb = Epi::PERM ? ((R & ~31) + perm32(R & 31)) : R;
        voffA[i] = (unsigned)(R * K + C) * 2u; voffB[i] = (unsigned)(Rb * K + C) * 2u; }
    const size_t kstep = (size_t)(BK * 2);
    const size_t hstep = (size_t)HALF * K * 2;
    const size_t tstep = 2 * hstep;
    const unsigned ldsw = (unsigned)wid * 1024u;
    const int aoff = lds_byte(wr * 64 + fr, fq * 8), boff = lds_byte(wc * 32 + fr, fq * 8);
#define PG8_SA(b, h) (((b) * 2 + (h)) * HTB)
#define PG8_SB(b, h) ((4 + (b) * 2 + (h)) * HTB)
#define PG8_STAGE(bufoff, gbase, voff) do { _Pragma("unroll") for (int _i = 0; _i < 2; ++_i) \
        __builtin_amdgcn_global_load_lds((const unsigned*)((const char*)(gbase) + (voff)[_i]), (PG8_LAS unsigned*)(lds + (bufoff) + ldsw + _i * 8192), 16, 0, 0); } while (0)
#define PG8_LDA(dst, b, h) do { _Pragma("unroll") for (int m = 0; m < 4; ++m) _Pragma("unroll") for (int k = 0; k < 2; ++k) dst[m][k] = *(const PG8_LAS bf16x8*)(lds + PG8_SA(b, h) + aoff + m * 2048 + k * 1024); } while (0)
#define PG8_LDB(dst, b, h) do { _Pragma("unroll") for (int n = 0; n < 2; ++n) _Pragma("unroll") for (int k = 0; k < 2; ++k) dst[n][k] = *(const PG8_LAS bf16x8*)(lds + PG8_SB(b, h) + boff + n * 2048 + k * 1024); } while (0)
#define PG8_MMA(ai, bj, At, Bt) do { __builtin_amdgcn_s_setprio(1); _Pragma("unroll") for (int m = 0; m < 4; ++m) _Pragma("unroll") for (int n = 0; n < 2; ++n) _Pragma("unroll") for (int k = 0; k < 2; ++k) \
        acc[ai][bj][m][n] = __builtin_amdgcn_mfma_f32_16x16x32_bf16(Bt[n][k], At[m][k], acc[ai][bj][m][n], 0, 0, 0); __builtin_amdgcn_s_setprio(0); } while (0)
#define PG8_WAIT_V(n) asm volatile("s_waitcnt vmcnt(" #n ")" ::: "memory")
#define PG8_WAIT_L(n) asm volatile("s_waitcnt lgkmcnt(" #n ")" ::: "memory")
#define PG8_BAR __builtin_amdgcn_s_barrier()
#define PG8_SCHED __builtin_amdgcn_sched_barrier(0)
    Unit cur, nxt; int ui = 0;
    if (!S.next(0, cur)) return;
    f32x4 acc[2][2][4][2];
#pragma unroll
    for (int a = 0; a < 2; ++a)
#pragma unroll
        for (int b = 0; b < 2; ++b)
#pragma unroll
            for (int m = 0; m < 4; ++m)
#pragma unroll
                for (int n = 0; n < 2; ++n) acc[a][b][m][n] = (f32x4){0.f, 0.f, 0.f, 0.f};
    bf16x8 At[4][2], B0[2][2], B1[2][2];
    const char* cA = (const char*)g.A + (size_t)cur.pm * tstep; const char* cB = (const char*)g.Bt + (size_t)cur.pn * tstep;
    S.a_ready(cur);
    PG8_STAGE(PG8_SB(0, 0), cB, voffB); PG8_STAGE(PG8_SA(0, 0), cA, voffA); PG8_STAGE(PG8_SB(0, 1), cB + hstep, voffB); PG8_STAGE(PG8_SA(0, 1), cA + hstep, voffA);
    if (wr == 1) PG8_BAR;
    PG8_WAIT_V(4); PG8_BAR;
    PG8_STAGE(PG8_SB(1, 0), cB + kstep, voffB); PG8_STAGE(PG8_SA(1, 0), cA + kstep, voffA); PG8_STAGE(PG8_SB(1, 1), cB + hstep + kstep, voffB);
    PG8_WAIT_V(6); PG8_BAR;
    for (;;) {
        const bool has_next = S.next(ui + 1, nxt);
        const char* nA = has_next ? (const char*)g.A + (size_t)nxt.pm * tstep : cA; const char* nB = has_next ? (const char*)g.Bt + (size_t)nxt.pn * tstep : cB;
        for (int t = 0; t < nt; t += 2) {
            const bool last = (t == nt - 2);
            const char* a1 = cA + (size_t)(t + 1) * kstep;
            const char* a2 = last ? nA : cA + (size_t)(t + 2) * kstep; const char* b2 = last ? nB : cB + (size_t)(t + 2) * kstep;
            const char* a3 = a2 + kstep; const char* b3 = b2 + kstep;
            if (last && has_next) S.a_ready(nxt);
            PG8_LDB(B0, 0, 0); PG8_SCHED; PG8_LDA(At, 0, 0); PG8_STAGE(PG8_SA(1, 1), a1 + hstep, voffA);
            PG8_WAIT_L(8); PG8_BAR; PG8_WAIT_L(0); PG8_MMA(0, 0, At, B0); PG8_BAR; PG8_SCHED;
            PG8_LDB(B1, 0, 1); PG8_STAGE(PG8_SB(0, 0), b2, voffB);
            PG8_BAR; PG8_WAIT_L(0); PG8_MMA(0, 1, At, B1); PG8_BAR;
            PG8_LDA(At, 0, 1); PG8_STAGE(PG8_SA(0, 0), a2, voffA);
            PG8_BAR; PG8_WAIT_L(0); PG8_MMA(1, 0, At, B0); PG8_BAR; PG8_SCHED;
            PG8_STAGE(PG8_SB(0, 1), b2 + hstep, voffB);
            PG8_WAIT_V(6); PG8_BAR; PG8_MMA(1, 1, At, B1); PG8_BAR;
            PG8_LDB(B0, 1, 0); PG8_SCHED; PG8_LDA(At, 1, 0); PG8_STAGE(PG8_SA(0, 1), a2 + hstep, voffA);
            PG8_WAIT_L(8); PG8_BAR; PG8_WAIT_L(0); PG8_MMA(0, 0, At, B0); PG8_BAR; PG8_SCHED;
            PG8_LDB(B1, 1, 1); PG8_STAGE(PG8_SB(1, 0), b3, voffB);
            PG8_BAR; PG8_WAIT_L(0); PG8_MMA(0, 1, At, B1); PG8_BAR;
            PG8_LDA(At, 1, 1); PG8_STAGE(PG8_SA(1, 0), a3, voffA);
            PG8_BAR; PG8_WAIT_L(0); PG8_MMA(1, 0, At, B0); PG8_BAR; PG8_SCHED;
            PG8_STAGE(PG8_SB(1, 1), b3 + hstep, voffB);
            PG8_WAIT_V(6); PG8_BAR; PG8_MMA(1, 1, At, B1); PG8_BAR;
        }
        if constexpr (!Epi::AFTER_DRAIN) { E(acc, cur, wr, wc, fr, fq); S.done(cur); }
        if (!has_next) break;
#pragma unroll
        for (int a = 0; a < 2; ++a)
#pragma unroll
            for (int b = 0; b < 2; ++b)
#pragma unroll
                for (int m = 0; m < 4; ++m)
#pragma unroll
                    for (int n = 0; n < 2; ++n) acc[a][b][m][n] = (f32x4){0.f, 0.f, 0.f, 0.f};
        cur = nxt; cA = nA; cB = nB; ++ui;
    }
    PG8_WAIT_V(0);
    if (wr == 0) PG8_BAR;
    PG8_BAR;
    if constexpr (Epi::AFTER_DRAIN) { E.fused(acc, cur, wr, wc, fr, fq, lds, wid, lane); S.done(cur); }
#undef PG8_SA
#undef PG8_SB
#undef PG8_STAGE
#undef PG8_LDA
#undef PG8_LDB
#undef PG8_MMA
#undef PG8_WAIT_V
#undef PG8_WAIT_L
#undef PG8_BAR
#undef PG8_SCHED
}
}
#define LAS __attribute__((address_space(3)))
#define GAS __attribute__((address_space(1)))
typedef unsigned short bf16_t;
typedef short bf16x8 __attribute__((ext_vector_type(8)));
typedef float f32x4 __attribute__((ext_vector_type(4)));
typedef float f32x2 __attribute__((ext_vector_type(2)));
typedef float f32x16 __attribute__((ext_vector_type(16)));
typedef unsigned u32x4 __attribute__((ext_vector_type(4)));
typedef unsigned u32x2 __attribute__((ext_vector_type(2)));
typedef LAS unsigned char* lptr;

constexpr int D = 1024, NB = 16, SEQ = 4096, CTX = 256, DEPTH = 4;
constexpr int GB = 8, NGRP = 2;
constexpr int RC = GB * CTX;
constexpr int RL = GB * SEQ;
constexpr int MG = RC + RL;
constexpr int RCX = GB * 320;
constexpr int MGX = RCX + RL;
constexpr int INW = 9216, DFF = 2816, NUP = 2 * DFF;
constexpr int O_RGX = 0, O_RGG = 1024, O_HG = 2048, O_GA = 7168, O_GB = 8192;
constexpr float EPS = 1e-6f;
constexpr int NTHREADS = 512;
constexpr int LDS_BYTES = 147456;
constexpr int XB_LDS_OFF = 147456 - 64;

constexpr size_t MiB = 1u << 20;
constexpr size_t WS_MOD = 1 * MiB;
constexpr size_t WS_LB = 2 * MiB + 768 * 1024;
constexpr size_t WS_XC = 3 * MiB;
constexpr size_t WS_WIN = 19 * MiB;
constexpr size_t WS_WPRG = 37 * MiB, WS_WPHG = 39 * MiB, WS_WOUT = 41 * MiB;
constexpr size_t WS_WUP = 43 * MiB;
constexpr size_t WS_WDN = 54 * MiB;
constexpr size_t WS_H = 60 * MiB;
constexpr size_t WS_R0 = 129 * MiB;
constexpr size_t WS_OF = 197 * MiB;
constexpr size_t WS_OB = 265 * MiB;
constexpr size_t WS_Z = 333 * MiB;
constexpr size_t WS_END = 945 * MiB;

__device__ __forceinline__ unsigned f2bf(float f) { unsigned u = __float_as_uint(f); return (u + 0x7fffu + ((u >> 16) & 1u)) >> 16; }
__device__ __forceinline__ unsigned pk2(float lo, float hi) { unsigned r; asm("v_cvt_pk_bf16_f32 %0, %1, %2" : "=v"(r) : "v"(lo), "v"(hi)); return r; }
__device__ __forceinline__ float bflo(unsigned w) { return __uint_as_float(w << 16); }
__device__ __forceinline__ float bfhi(unsigned w) { return __uint_as_float(w & 0xffff0000u); }
__device__ __forceinline__ float bf1(unsigned short s) { return __uint_as_float(((unsigned)s) << 16); }
__device__ __forceinline__ float sigm(float x) { return __builtin_amdgcn_rcpf(1.0f + __builtin_amdgcn_exp2f(-1.4426950408889634f * x)); }
__device__ __forceinline__ float wave_sum(float v) {
#pragma unroll
    for (int o = 1; o < 64; o <<= 1) v += __shfl_xor(v, o);
    return v;
}
#define LBAR() do { asm volatile("s_waitcnt lgkmcnt(0)" ::: "memory"); __builtin_amdgcn_s_barrier(); asm volatile("" ::: "memory"); } while (0)
#define MFMA32(a, b, c) __builtin_amdgcn_mfma_f32_32x32x16_bf16((a), (b), (c), 0, 0, 0)
__device__ __forceinline__ int crow(int reg, int h) { return (reg & 3) + 8 * (reg >> 2) + 4 * h; }

struct EpiStore {
    static constexpr bool PERM = true, AFTER_DRAIN = false;
    GAS bf16_t* O; int ldc; int row_off;
    __device__ __forceinline__ void operator()(const f32x4 (&acc)[2][2][4][2], const pg8::Unit& u, int wr, int wc, int fr, int fq) const {
        const int row0 = row_off + u.pm * 256 + wr * 64 + fr, col0 = u.pn * 256 + wc * 32 + 8 * fq;
#pragma unroll
        for (int ai = 0; ai < 2; ++ai)
#pragma unroll
            for (int m = 0; m < 4; ++m) { GAS bf16_t* rowp = O + (size_t)(row0 + ai * 128 + m * 16) * ldc + col0;
#pragma unroll
                for (int bj = 0; bj < 2; ++bj) { const f32x4 v0 = acc[ai][bj][m][0], v1 = acc[ai][bj][m][1];
                    u32x4 w; w.x = pg8::cvt_pk_bf16(v0[0], v0[1]); w.y = pg8::cvt_pk_bf16(v0[2], v0[3]); w.z = pg8::cvt_pk_bf16(v1[0], v1[1]); w.w = pg8::cvt_pk_bf16(v1[2], v1[3]);
                    *(GAS u32x4*)(rowp + bj * 128) = w; } }
    }
};
struct EpiZ {
    static constexpr bool PERM = true, AFTER_DRAIN = false;
    GAS bf16_t* O; const GAS float* lb;
    __device__ __forceinline__ void operator()(const f32x4 (&acc)[2][2][4][2], const pg8::Unit& u, int wr, int wc, int fr, int fq) const {
        const int row0 = u.pm * 256 + wr * 64 + fr, col0 = u.pn * 256 + wc * 32 + 8 * fq;
        const int ct = u.pn * 256;
        const int mode = (ct >= O_HG && ct < O_HG + 1024) ? 1 : ((ct >= O_HG + 1024 && ct < O_HG + 3072) ? 2 : 0);
        float lbv[2][8];
        if (mode == 2) {
#pragma unroll
            for (int bj = 0; bj < 2; ++bj) { const GAS float* lp = lb + ((col0 + bj * 128) & 1023); const f32x4 a = *(const GAS f32x4*)lp, b = *(const GAS f32x4*)(lp + 4);
#pragma unroll
                for (int j = 0; j < 4; ++j) { lbv[bj][j] = a[j]; lbv[bj][4 + j] = b[j]; } }
        }
#pragma unroll
        for (int ai = 0; ai < 2; ++ai)
#pragma unroll
            for (int m = 0; m < 4; ++m) { GAS bf16_t* rowp = O + (size_t)(row0 + ai * 128 + m * 16) * INW + col0;
#pragma unroll
                for (int bj = 0; bj < 2; ++bj) { const f32x4 v0 = acc[ai][bj][m][0], v1 = acc[ai][bj][m][1];
                    float o[8] = {v0[0], v0[1], v0[2], v0[3], v1[0], v1[1], v1[2], v1[3]};
                    u32x4 w;
                    if (mode == 2) { unsigned hb[8];
#pragma unroll
                        for (int j = 0; j < 8; ++j) { const float z = fminf(fmaxf(o[j], -30.f), 30.f); const float lbj = lbv[bj][j]; const float lf = __builtin_amdgcn_logf(lbj + (1.0f - lbj) * sigm(z));
                            hb[j] = (unsigned)__builtin_bit_cast(unsigned short, (_Float16)lf); }
                        w.x = hb[0] | (hb[1] << 16); w.y = hb[2] | (hb[3] << 16); w.z = hb[4] | (hb[5] << 16); w.w = hb[6] | (hb[7] << 16);
                    } else {
                        if (mode == 1) {
#pragma unroll
                            for (int j = 0; j < 8; ++j) o[j] = o[j] * sigm(o[j]); }
                        w.x = pg8::cvt_pk_bf16(o[0], o[1]); w.y = pg8::cvt_pk_bf16(o[2], o[3]); w.z = pg8::cvt_pk_bf16(o[4], o[5]); w.w = pg8::cvt_pk_bf16(o[6], o[7]);
                    }
                    *(GAS u32x4*)(rowp + bj * 128) = w; } }
    }
};
template <int MODE> struct EpiGate {
    static constexpr bool PERM = true, AFTER_DRAIN = false;
    const GAS bf16_t* Zg; const GAS bf16_t* T; GAS bf16_t* O; int row_off;
    __device__ __forceinline__ void operator()(const f32x4 (&acc)[2][2][4][2], const pg8::Unit& u, int wr, int wc, int fr, int fq) const {
        const int row0 = row_off + u.pm * 256 + wr * 64 + fr, col0 = u.pn * 256 + wc * 32 + 8 * fq;
#pragma unroll
        for (int ai = 0; ai < 2; ++ai) {
            u32x4 gw[4][2], tw[4][2];
#pragma unroll
            for (int m = 0; m < 4; ++m)
#pragma unroll
                for (int bj = 0; bj < 2; ++bj) { const size_t row = (size_t)(row0 + ai * 128 + m * 16); const int col = col0 + bj * 128;
                    gw[m][bj] = *(const GAS u32x4*)(Zg + row * INW + col); if (MODE == 1) tw[m][bj] = *(const GAS u32x4*)(T + row * D + col); }
#pragma unroll
            for (int m = 0; m < 4; ++m)
#pragma unroll
                for (int bj = 0; bj < 2; ++bj) { const size_t row = (size_t)(row0 + ai * 128 + m * 16); const int col = col0 + bj * 128;
                    const u32x4 g4 = gw[m][bj];
                    const f32x4 v0 = acc[ai][bj][m][0], v1 = acc[ai][bj][m][1];
                    float o[8];
                    o[0] = sigm(bflo(g4.x)) * v0[0]; o[1] = sigm(bfhi(g4.x)) * v0[1]; o[2] = sigm(bflo(g4.y)) * v0[2]; o[3] = sigm(bfhi(g4.y)) * v0[3];
                    o[4] = sigm(bflo(g4.z)) * v1[0]; o[5] = sigm(bfhi(g4.z)) * v1[1]; o[6] = sigm(bflo(g4.w)) * v1[2]; o[7] = sigm(bfhi(g4.w)) * v1[3];
                    if (MODE == 1) { const u32x4 t4 = tw[m][bj];
                        o[0] += bflo(t4.x); o[1] += bfhi(t4.x); o[2] += bflo(t4.y); o[3] += bfhi(t4.y); o[4] += bflo(t4.z); o[5] += bfhi(t4.z); o[6] += bflo(t4.w); o[7] += bfhi(t4.w); }
                    u32x4 w; w.x = pg8::cvt_pk_bf16(o[0], o[1]); w.y = pg8::cvt_pk_bf16(o[2], o[3]); w.z = pg8::cvt_pk_bf16(o[4], o[5]); w.w = pg8::cvt_pk_bf16(o[6], o[7]);
                    *(GAS u32x4*)(O + row * D + col) = w; }
        }
    }
};
struct EpiUp {
    static constexpr bool PERM = true, AFTER_DRAIN = false;
    GAS bf16_t* ACT; const GAS float* cw; const GAS float* cb; int pm_off;
    __device__ __forceinline__ void operator()(const f32x4 (&acc)[2][2][4][2], const pg8::Unit& u, int wr, int wc, int fr, int fq) const {
        const int lane = tid_opaque() & 63;
        const int ch0 = u.pn * 128 + wc * 32 + 8 * fq;
        const int pmv = u.pm + pm_off;
        const int lup = (lane & 48) | ((lane + 1) & 15), ldn = (lane & 48) | ((lane - 1) & 15);
        f32x4 cw0[2], cw1[2], cw2[2], cbb[2];
#pragma unroll
        for (int n = 0; n < 2; ++n) { const int chn = ch0 + 4 * n; cw0[n] = *(const GAS f32x4*)(cw + chn); cw1[n] = *(const GAS f32x4*)(cw + DFF + chn); cw2[n] = *(const GAS f32x4*)(cw + 2 * DFF + chn); cbb[n] = *(const GAS f32x4*)(cb + chn); }
#pragma unroll
        for (int ai = 0; ai < 2; ++ai) {
            long drow[4]; bool ok[4];
#pragma unroll
            for (int m = 0; m < 4; ++m) {
                const int r64 = 16 * m + fr; ok[m] = true;
                if (pmv < 10) { const int G = pmv * 4 + ai * 2 + wr, bl = G / 5, gi = G - bl * 5, tok = 62 * gi - 1 + r64; ok[m] = (r64 >= 1) && (r64 <= 62) && (tok < CTX); drow[m] = (long)bl * CTX + tok; }
                else drow[m] = (long)RC + (long)(pmv - 10) * 256 + ai * 128 + wr * 64 + r64;
            }
            unsigned pw[4][4];
#pragma unroll
            for (int n = 0; n < 2; ++n) {
                const f32x4 w0 = cw0[n], w1 = cw1[n], w2 = cw2[n], bb = cbb[n];
#pragma unroll
                for (int jp = 0; jp < 2; ++jp) {
                    float res[2][4];
#pragma unroll
                    for (int jj = 0; jj < 2; ++jj) { const int j = 2 * jp + jj;
                        float ru[4], rd[4];
#pragma unroll
                        for (int m = 0; m < 4; ++m) { const int gi = __float_as_int(acc[ai][0][m][n][j]);
                            ru[m] = __int_as_float(__builtin_amdgcn_update_dpp(0, gi, 0x12F, 0xf, 0xf, false)); rd[m] = __int_as_float(__builtin_amdgcn_update_dpp(0, gi, 0x121, 0xf, 0xf, false)); }
#pragma unroll
                        for (int m = 0; m < 4; ++m) {
                            const float up = (fr < 15) ? ru[m] : (m < 3 ? ru[m < 3 ? m + 1 : 3] : 0.f);
                            const float dn = (fr > 0) ? rd[m] : (m > 0 ? rd[m > 0 ? m - 1 : 0] : 0.f);
                            const float cv = bb[j] + w0[j] * dn + w1[j] * acc[ai][0][m][n][j] + w2[j] * up;
                            res[jj][m] = cv * sigm(cv) * acc[ai][1][m][n][j];
                        } }
#pragma unroll
                    for (int m = 0; m < 4; ++m) pw[m][2 * n + jp] = pg8::cvt_pk_bf16(res[0][m], res[1][m]);
                }
            }
#pragma unroll
            for (int m = 0; m < 4; ++m) if (ok[m]) { u32x4 w; w.x = pw[m][0]; w.y = pw[m][1]; w.z = pw[m][2]; w.w = pw[m][3]; *(GAS u32x4*)(ACT + (size_t)drow[m] * DFF + ch0) = w; }
        }
    }
};

template <bool UPMAP>
__device__ __forceinline__ void conv_item(const GAS float* W, int K, int N, GAS bf16_t* WT, LAS float* scr, int item, int lane) {
    const int nblk = N / 32, kb = item / nblk, nb = item % nblk, k0 = 64 * kb, n0 = 32 * nb;
    float wv[32];
#pragma unroll
    for (int i = 0; i < 32; ++i) { const int kk = 2 * i + (lane >> 5); wv[i] = __builtin_nontemporal_load(W + (size_t)(k0 + kk) * N + n0 + (lane & 31)); }
#pragma unroll
    for (int i = 0; i < 32; ++i) { const int kk = 2 * i + (lane >> 5); scr[kk * 33 + (lane & 31)] = wv[i]; }
    asm volatile("s_waitcnt lgkmcnt(0)" ::: "memory");
    int d0 = n0;
    if (UPMAP) { if (n0 < DFF) d0 = (n0 >> 7) * 256 + (n0 & 127); else { const int n2 = n0 - DFF; d0 = (n2 >> 7) * 256 + 128 + (n2 & 127); } }
    const int c = lane & 7;
#pragma unroll
    for (int j = 0; j < 4; ++j) { const int n = (lane >> 3) + 8 * j; const LAS float* s = scr + (8 * c) * 33 + n;
        u32x4 o; o.x = pk2(s[0 * 33], s[1 * 33]); o.y = pk2(s[2 * 33], s[3 * 33]); o.z = pk2(s[4 * 33], s[5 * 33]); o.w = pk2(s[6 * 33], s[7 * 33]);
        *(GAS u32x4*)(WT + (size_t)(d0 + n) * K + k0 + 8 * c) = o; }
    asm volatile("s_waitcnt lgkmcnt(0)" ::: "memory");
}
struct Ptrs {
    const GAS float*x, *c, *ctx, *c_ctx, *w_ada, *b_ada, *g_pre_mix, *g_post_mix, *g_pre_ffn, *g_post_ffn, *w_in, *rg_conv_w, *rg_conv_b, *rg_wa, *rg_ba, *rg_wx, *rg_bx, *rg_lam,
        *hg_lb, *hg_out_norm, *w_proj_rg, *w_proj_hg, *w_out, *ffn_w_up, *ffn_conv_w, *ffn_conv_b, *ffn_w_down;
    GAS float* out; GAS unsigned char* ws;
};
__device__ __forceinline__ void convert_weights(const Ptrs& P, lptr lds, int l, int part = 0, int skip = 0) {
    const int lane = tid_opaque() & 63, wave = __builtin_amdgcn_readfirstlane(tid_opaque() >> 6);
    LAS float* scr = (LAS float*)(lds + wave * 8448);
    if ((int)blockIdx.x < skip) return;
    const int gw = ((int)blockIdx.x - skip) * 8 + wave, NGW = ((int)gridDim.x - skip) * 8;
    constexpr int I_IN = 16 * 288, I_P = 16 * 32, I_UP = 16 * 176, I_DN = 44 * 32, NIT = I_IN + 3 * I_P + I_UP + I_DN;
    const int it_lo = (part == 2) ? NIT - I_DN : 0, it_hi = (part == 1) ? NIT - I_DN : NIT;
    for (int it = it_lo + gw; it < it_hi; it += NGW) {
        int r = it;
        if (r < I_IN) { conv_item<false>(P.w_in + (size_t)l * D * INW, D, INW, (GAS bf16_t*)(P.ws + WS_WIN), scr, r, lane); continue; } r -= I_IN;
        if (r < I_P) { conv_item<false>(P.w_proj_rg + (size_t)l * D * D, D, D, (GAS bf16_t*)(P.ws + WS_WPRG), scr, r, lane); continue; } r -= I_P;
        if (r < I_P) { conv_item<false>(P.w_proj_hg + (size_t)l * D * D, D, D, (GAS bf16_t*)(P.ws + WS_WPHG), scr, r, lane); continue; } r -= I_P;
        if (r < I_P) { conv_item<false>(P.w_out + (size_t)l * D * D, D, D, (GAS bf16_t*)(P.ws + WS_WOUT), scr, r, lane); continue; } r -= I_P;
        if (r < I_UP) { conv_item<true>(P.ffn_w_up + (size_t)l * D * NUP, D, NUP, (GAS bf16_t*)(P.ws + WS_WUP), scr, r, lane); continue; } r -= I_UP;
        conv_item<false>(P.ffn_w_down + (size_t)l * DFF * D, DFF, D, (GAS bf16_t*)(P.ws + WS_WDN), scr, r, lane);
    }
}
__device__ __forceinline__ void mods_phase(const Ptrs& P, lptr lds) {
    const int tid = tid_opaque(), lane = tid & 63, wave = __builtin_amdgcn_readfirstlane(tid >> 6);
    LAS float* S = (LAS float*)lds;
    LAS float* RED = (LAS float*)(lds + 17 * 1024 * 4);
    GAS float* MOD = (GAS float*)(P.ws + WS_MOD);
    for (int idx = tid; idx < 17 * 1024; idx += NTHREADS) { const int r = idx >> 10, k = idx & 1023; const float v = r < 16 ? P.c[r * 1024 + k] : P.c_ctx[k]; S[idx] = v * sigm(v); }
    if (blockIdx.x == 0) { GAS float* LB = (GAS float*)(P.ws + WS_LB);
        for (int c = tid; c < 1024; c += NTHREADS) { const float p0 = P.hg_lb[c], p1 = P.hg_lb[1024 + c], p2 = P.hg_lb[2048 + c], p3 = P.hg_lb[3072 + c];
            const float mx = fmaxf(fmaxf(p0, p1), fmaxf(p2, p3)); const float e0 = expf(p0 - mx), e1 = expf(p1 - mx), e2 = expf(p2 - mx), e3 = expf(p3 - mx); const float inv = 1.0f / (e0 + e1 + e2 + e3);
            LB[c] = 0.f; LB[1024 + c] = e1 * inv; LB[2048 + c] = (e1 + e2) * inv; LB[3072 + c] = (e1 + e2 + e3) * inv; } }
    __syncthreads();
    for (int task = blockIdx.x; task < 4 * 96; task += gridDim.x) {
        const int l = task / 96, n0 = (task % 96) * 64;
        float acc[17];
#pragma unroll
        for (int r = 0; r < 17; ++r) acc[r] = 0.f;
        const GAS float* wp = P.w_ada + ((size_t)l * 1024 + wave * 128) * 6144 + n0 + lane;
#pragma unroll 4
        for (int kk = 0; kk < 128; ++kk) { const float w = __builtin_nontemporal_load(wp + (size_t)kk * 6144);
#pragma unroll
            for (int r = 0; r < 17; ++r) acc[r] += S[r * 1024 + wave * 128 + kk] * w; }
#pragma unroll
        for (int r = 0; r < 17; ++r) RED[(wave * 17 + r) * 64 + lane] = acc[r];
        __syncthreads();
        for (int idx = tid; idx < 17 * 64; idx += NTHREADS) { const int r = idx >> 6, ln = idx & 63; float s = P.b_ada[l * 6144 + n0 + ln];
#pragma unroll
            for (int w = 0; w < 8; ++w) s += RED[(w * 17 + r) * 64 + ln];
            MOD[(size_t)(l * 17 + r) * 6144 + n0 + ln] = s; }
        __syncthreads();
    }
}
__device__ __forceinline__ const GAS float* modp(const Ptrs& P, int l, int r, int j) { return (const GAS float*)(P.ws + WS_MOD) + ((size_t)(l * 17 + r) * 6 + j) * 1024; }

__device__ __forceinline__ void row_op(const GAS float* xsrc, GAS float* xdst, const GAS bf16_t* y, const GAS float* gate, const GAS float* gpost,
                                       const GAS float* gpre, const GAS float* mscale, const GAS float* mshift, GAS bf16_t* h0, GAS bf16_t* h1, int lane) {
    f32x4 v[4];
#pragma unroll
    for (int j = 0; j < 4; ++j) v[j] = *((const GAS f32x4*)xsrc + lane + 64 * j);
    if (y) {
        f32x4 yy[4]; float ss = 0.f;
#pragma unroll
        for (int j = 0; j < 4; ++j) { const u32x2 w = *((const GAS u32x2*)y + lane + 64 * j); yy[j] = (f32x4){bflo(w.x), bfhi(w.x), bflo(w.y), bfhi(w.y)};
            ss += (yy[j][0] * yy[j][0] + yy[j][1] * yy[j][1]) + (yy[j][2] * yy[j][2] + yy[j][3] * yy[j][3]); }
        const float r = __builtin_amdgcn_rsqf(wave_sum(ss) * (1.0f / 1024.0f) + EPS);
#pragma unroll
        for (int j = 0; j < 4; ++j) { const f32x4 gt = *((const GAS f32x4*)gate + lane + 64 * j), gp = *((const GAS f32x4*)gpost + lane + 64 * j); v[j] = v[j] + gt * (yy[j] * r * gp); }
        if (xdst) {
#pragma unroll
            for (int j = 0; j < 4; ++j) *((GAS f32x4*)xdst + lane + 64 * j) = v[j]; }
    }
    if (h0) {
        float s2 = 0.f;
#pragma unroll
        for (int j = 0; j < 4; ++j) s2 += (v[j][0] * v[j][0] + v[j][1] * v[j][1]) + (v[j][2] * v[j][2] + v[j][3] * v[j][3]);
        const float r2 = __builtin_amdgcn_rsqf(wave_sum(s2) * (1.0f / 1024.0f) + EPS);
#pragma unroll
        for (int j = 0; j < 4; ++j) { const f32x4 gp = *((const GAS f32x4*)gpre + lane + 64 * j), sc = *((const GAS f32x4*)mscale + lane + 64 * j), sh = *((const GAS f32x4*)mshift + lane + 64 * j);
            const f32x4 hv = (v[j] * r2 * gp) * (sc + 1.0f) + sh;
            u32x2 w; w.x = pk2(hv[0], hv[1]); w.y = pk2(hv[2], hv[3]);
            *((GAS u32x2*)h0 + lane + 64 * j) = w; if (h1) *((GAS u32x2*)h1 + lane + 64 * j) = w; }
    }
}
template <int NR, bool HASY, bool HASH>
__device__ __forceinline__ void row_block(const GAS float* xsrc, GAS float* xdst, const GAS bf16_t* y, GAS bf16_t* h, const f32x4 (&A1)[4], const f32x4 (&A2)[4], const f32x4 (&A3)[4], int lane) {
    f32x4 v[NR][4]; f32x4 yy[NR][4]; float ss[NR];
#pragma unroll
    for (int q = 0; q < NR; ++q)
#pragma unroll
        for (int j = 0; j < 4; ++j) v[q][j] = __builtin_nontemporal_load((const GAS f32x4*)(xsrc + (size_t)q * D) + lane + 64 * j);
    if (HASY) {
#pragma unroll
        for (int q = 0; q < NR; ++q) { ss[q] = 0.f;
#pragma unroll
            for (int j = 0; j < 4; ++j) { const u32x2 w = __builtin_nontemporal_load((const GAS u32x2*)(y + (size_t)q * D) + lane + 64 * j); yy[q][j] = (f32x4){bflo(w.x), bfhi(w.x), bflo(w.y), bfhi(w.y)};
                ss[q] += (yy[q][j][0] * yy[q][j][0] + yy[q][j][1] * yy[q][j][1]) + (yy[q][j][2] * yy[q][j][2] + yy[q][j][3] * yy[q][j][3]); } }
#pragma unroll
        for (int o = 1; o < 64; o <<= 1) {
#pragma unroll
            for (int q = 0; q < NR; ++q) ss[q] += __shfl_xor(ss[q], o); }
#pragma unroll
        for (int q = 0; q < NR; ++q) { const float r = __builtin_amdgcn_rsqf(ss[q] * (1.0f / 1024.0f) + EPS);
#pragma unroll
            for (int j = 0; j < 4; ++j) { v[q][j] = v[q][j] + A1[j] * (yy[q][j] * r); __builtin_nontemporal_store(v[q][j], (GAS f32x4*)(xdst + (size_t)q * D) + lane + 64 * j); } }
    }
    if (HASH) {
        float s2[NR];
#pragma unroll
        for (int q = 0; q < NR; ++q) { s2[q] = 0.f;
#pragma unroll
            for (int j = 0; j < 4; ++j) s2[q] += (v[q][j][0] * v[q][j][0] + v[q][j][1] * v[q][j][1]) + (v[q][j][2] * v[q][j][2] + v[q][j][3] * v[q][j][3]); }
#pragma unroll
        for (int o = 1; o < 64; o <<= 1) {
#pragma unroll
            for (int q = 0; q < NR; ++q) s2[q] += __shfl_xor(s2[q], o); }
#pragma unroll
        for (int q = 0; q < NR; ++q) { const float r2 = __builtin_amdgcn_rsqf(s2[q] * (1.0f / 1024.0f) + EPS);
#pragma unroll
            for (int j = 0; j < 4; ++j) { const f32x4 hv = (v[q][j] * r2) * A2[j] + A3[j]; u32x2 w; w.x = pg8::cvt_pk_bf16(hv[0], hv[1]); w.y = pg8::cvt_pk_bf16(hv[2], hv[3]); *((GAS u32x2*)(h + (size_t)q * D) + lane + 64 * j) = w; } }
    }
}
__device__ __forceinline__ void rowop_phase(const Ptrs& P, int kind, int g, int l) {
    const int lane = tid_opaque() & 63, wave = __builtin_amdgcn_readfirstlane(tid_opaque() >> 6);
    const int gw = blockIdx.x * 8 + wave, NGW = gridDim.x * 8;
    GAS bf16_t* H = (GAS bf16_t*)(P.ws + WS_H); const GAS bf16_t* Y = (const GAS bf16_t*)(P.ws + WS_OF); GAS float* XC = (GAS float*)(P.ws + WS_XC);
    for (int blk = gw; blk < RL / 16; blk += NGW) {
        const int rl = blk * 16, b = g * GB + (rl >> 12); const size_t xrow = (size_t)(b * SEQ + (rl & 4095)) * D; const int r = RC + rl;
        const GAS float*pg = nullptr, *pp = nullptr, *pq, *psc, *psh;
        if (kind == 0) { pq = P.g_pre_mix + l * D; psc = modp(P, l, b, 1); psh = modp(P, l, b, 0); }
        else if (kind == 1) { pg = modp(P, l, b, 2); pp = P.g_post_mix + l * D; pq = P.g_pre_ffn + l * D; psc = modp(P, l, b, 4); psh = modp(P, l, b, 3); }
        else { const int ln = l < 3 ? l + 1 : l; pg = modp(P, l, b, 5); pp = P.g_post_ffn + l * D; pq = P.g_pre_mix + ln * D; psc = modp(P, ln, b, 1); psh = modp(P, ln, b, 0); }
        f32x4 A1[4], A2[4], A3[4];
#pragma unroll
        for (int j = 0; j < 4; ++j) { A1[j] = (kind == 0) ? (f32x4){0.f, 0.f, 0.f, 0.f} : *((const GAS f32x4*)pg + lane + 64 * j) * *((const GAS f32x4*)pp + lane + 64 * j);
            A2[j] = *((const GAS f32x4*)pq + lane + 64 * j) * (*((const GAS f32x4*)psc + lane + 64 * j) + 1.0f); A3[j] = *((const GAS f32x4*)psh + lane + 64 * j); }
        if (kind == 0) { for (int i = 0; i < 16; i += 2) row_block<2, false, true>(P.x + xrow + (size_t)i * D, nullptr, nullptr, H + (size_t)(r + i) * D, A1, A2, A3, lane); }
        else if (kind == 1) { const GAS float* xs = (l == 0 ? P.x : P.out) + xrow; for (int i = 0; i < 16; i += 2) row_block<2, true, true>(xs + (size_t)i * D, P.out + xrow + (size_t)i * D, Y + (size_t)(r + i) * D, H + (size_t)(RCX + rl + i) * D, A1, A2, A3, lane); }
        else if (l < 3) { for (int i = 0; i < 16; i += 2) row_block<2, true, true>(P.out + xrow + (size_t)i * D, P.out + xrow + (size_t)i * D, Y + (size_t)(r + i) * D, H + (size_t)(r + i) * D, A1, A2, A3, lane); }
        else { for (int i = 0; i < 16; i += 2) row_block<2, true, false>(P.out + xrow + (size_t)i * D, P.out + xrow + (size_t)i * D, Y + (size_t)(r + i) * D, nullptr, A1, A2, A3, lane); }
    }
    if (kind != 0 && l == 3) return;
    for (int r = gw; r < RC; r += NGW) {
        const int bl = r >> 8, tc = r & 255, b = g * GB + bl, mr = 16; const size_t xrow = (size_t)(b * CTX + tc) * D;
        if (kind == 0) {
            row_op(P.ctx + xrow, nullptr, nullptr, nullptr, nullptr, P.g_pre_mix + l * D, modp(P, l, mr, 1), modp(P, l, mr, 0), H + (size_t)r * D, nullptr, lane);
        } else if (kind == 1) {
            const GAS float* xs = (l == 0 ? P.ctx : XC) + xrow; GAS float* xd = XC + xrow;
            GAS bf16_t*h0, *h1 = nullptr;
            const int gi = tc / 62, rr = tc - gi * 62 + 1; GAS bf16_t* hb = H + (size_t)(bl * 320) * D;
            h0 = hb + (size_t)(gi * 64 + rr) * D;
            if (rr == 62 && gi < 4) h1 = hb + (size_t)((gi + 1) * 64) * D;
            else if (rr == 1 && gi > 0) h1 = hb + (size_t)((gi - 1) * 64 + 63) * D;
            if (tc == 0) { u32x2 zz; zz.x = 0u; zz.y = 0u;
#pragma unroll
                for (int j = 0; j < 4; ++j) *((GAS u32x2*)hb + lane + 64 * j) = zz; }
            if (tc == 255) { u32x2 zz; zz.x = 0u; zz.y = 0u;
                for (int q = 9; q < 64; ++q) {
#pragma unroll
                    for (int j = 0; j < 4; ++j) *((GAS u32x2*)(hb + (size_t)(4 * 64 + q) * D) + lane + 64 * j) = zz; } }
            row_op(xs, xd, Y + (size_t)r * D, modp(P, l, mr, 2), P.g_post_mix + l * D, P.g_pre_ffn + l * D, modp(P, l, mr, 4), modp(P, l, mr, 3), h0, h1, lane);
        } else {
            GAS float* xd = XC + xrow;
            const bool nh = l < 3; const int ln = nh ? l + 1 : l;
            row_op(xd, xd, Y + (size_t)r * D, modp(P, l, mr, 5), P.g_post_ffn + l * D, P.g_pre_mix + ln * D, modp(P, ln, mr, 1), modp(P, ln, mr, 0), nh ? H + (size_t)r * D : nullptr, nullptr, lane);
        }
    }
}
__device__ __forceinline__ void hgout_phase(const Ptrs& P, int l, int skip) {
    const int lane = tid_opaque() & 63, wave = __builtin_amdgcn_readfirstlane(tid_opaque() >> 6);
    if ((int)blockIdx.x < skip) return;
    const int gw = ((int)blockIdx.x - skip) * 8 + wave, NGW = ((int)gridDim.x - skip) * 8;
    GAS bf16_t* OF = (GAS bf16_t*)(P.ws + WS_OF); const GAS bf16_t* OB = (const GAS bf16_t*)(P.ws + WS_OB); const GAS bf16_t* Z = (const GAS bf16_t*)(P.ws + WS_Z);
    const GAS float* gain = P.hg_out_norm + l * D + 16 * lane;
    float gn[16];
#pragma unroll
    for (int q = 0; q < 4; ++q) { const f32x4 t = *((const GAS f32x4*)gain + q); gn[4 * q] = t[0]; gn[4 * q + 1] = t[1]; gn[4 * q + 2] = t[2]; gn[4 * q + 3] = t[3]; }
    for (int r = (l == 3 ? RC : 0) + gw; r < MG; r += NGW) {
        const GAS u32x4* pf = (const GAS u32x4*)(OF + (size_t)r * D + 16 * lane); const GAS u32x4* pb = (const GAS u32x4*)(OB + (size_t)r * D + 16 * lane);
        const GAS u32x4* pg = (const GAS u32x4*)(Z + (size_t)r * INW + O_HG + 4 * 1024 + 16 * lane);
        float o[16], gv[16]; float ss = 0.f;
#pragma unroll
        for (int q = 0; q < 2; ++q) { const u32x4 a = pf[q], b = pb[q], c = pg[q];
            const unsigned aw[4] = {a.x, a.y, a.z, a.w}, bw[4] = {b.x, b.y, b.z, b.w}, cw4[4] = {c.x, c.y, c.z, c.w};
#pragma unroll
            for (int e = 0; e < 4; ++e) { const int i = 8 * q + 2 * e; o[i] = bflo(aw[e]) + bflo(bw[e]); o[i + 1] = bfhi(aw[e]) + bfhi(bw[e]); gv[i] = bflo(cw4[e]); gv[i + 1] = bfhi(cw4[e]); ss += o[i] * o[i] + o[i + 1] * o[i + 1]; } }
        ss += __shfl_xor(ss, 1); ss += __shfl_xor(ss, 2); ss += __shfl_xor(ss, 4);
        const float rr = __builtin_amdgcn_rsqf(ss * (1.0f / 128.0f) + EPS);
        u32x4 w[2];
#pragma unroll
        for (int q = 0; q < 2; ++q) { unsigned pw[4];
#pragma unroll
            for (int e = 0; e < 4; ++e) { const int i = 8 * q + 2 * e; const float y0 = o[i] * rr * gn[i] * (gv[i] * sigm(gv[i])), y1 = o[i + 1] * rr * gn[i + 1] * (gv[i + 1] * sigm(gv[i + 1])); pw[e] = pk2(y0, y1); }
            w[q].x = pw[0]; w[q].y = pw[1]; w[q].z = pw[2]; w[q].w = pw[3]; }
        GAS u32x4* po = (GAS u32x4*)(OF + (size_t)r * D + 16 * lane); po[0] = w[0]; po[1] = w[1];
    }
}
constexpr int HB_QI = 0, HB_KD = 8704, HB_KT = 17408, HB_VT = 27648, HB_E = 32768, HB_SZ = 33280;
constexpr int H_ST = 2 * HB_SZ, H_AM = H_ST + 64 * 272, H_TOT = H_AM + 32 * 80, H_END = H_TOT + 4096;
static_assert(H_END <= 131072, "hg lds");
__device__ __forceinline__ void hg_unit(const Ptrs& P, lptr lds, int l, int u) {
    const int tid = tid_opaque(), lane = tid & 63, wave = __builtin_amdgcn_readfirstlane(tid >> 6), l31 = lane & 31, hh = lane >> 5;
    const int bl = u >> 5, head = (u >> 2) & 7, dir = (u >> 1) & 1, vh = u & 1;
    const GAS bf16_t* Z = (const GAS bf16_t*)(P.ws + WS_Z);
    GAS bf16_t* O = (GAS bf16_t*)(P.ws + (dir ? WS_OB : WS_OF));
    const int kp = tid & 63, tg = tid >> 6;
    const GAS bf16_t* zq = Z + O_HG + head * 128 + 2 * kp;
    const GAS bf16_t* zf = Z + O_HG + (1 + dir) * 1024 + head * 128 + 2 * kp;
    const GAS bf16_t* zv = Z + O_HG + 3 * 1024 + head * 128 + vh * 64 + kp;
    GAS bf16_t* obase = O + head * 128 + vh * 64 + l31;
    for (int i = tid; i < 64 * 272 / 4; i += NTHREADS) *(LAS unsigned*)(lds + H_ST + 4 * i) = 0u;
    f32x16 Sacc;
#pragma unroll
    for (int i = 0; i < 16; ++i) Sacc[i] = 0.f;
    unsigned rq[4], rf[4]; unsigned short rv[4], cv[4];
    f32x2 bc[4], qv[4], kk[4];
#define HG_ROWS(j, rb, rs) long rb, rs; { const int _j = (j); if (_j < 8) { rs = dir ? -1 : 1; rb = (long)bl * CTX + (dir ? 255 - 32 * _j : 32 * _j); } \
        else { const int _m = _j - 8; const int _q0 = dir ? 4095 - 32 * _m : 32 * _m; rs = dir ? -64 : 64; rb = (long)RC + (long)bl * SEQ + (_q0 & 63) * 64 + (_q0 >> 6); } }
#define HG_LOAD(j) do { HG_ROWS(j, _rb, _rs); const long _o0 = (_rb + 4 * tg * _rs) * INW, _st = _rs * INW; \
        _Pragma("unroll") for (int i = 0; i < 4; ++i) { rq[i] = *(const GAS unsigned*)(zq + _o0 + i * _st); rf[i] = *(const GAS unsigned*)(zf + _o0 + i * _st); rv[i] = zv[_o0 + i * _st]; } } while (0)
#define HG_FEAT() do { f32x2 cum; cum.x = 0.f; cum.y = 0.f; _Pragma("unroll") for (int i = 0; i < 4; ++i) { qv[i].x = bflo(rq[i]); qv[i].y = bfhi(rq[i]); \
            f32x2 lf; lf.x = (float)__builtin_bit_cast(_Float16, (unsigned short)(rf[i] & 0xffffu)); lf.y = (float)__builtin_bit_cast(_Float16, (unsigned short)(rf[i] >> 16)); \
            f32x2 ef; ef.x = __builtin_amdgcn_exp2f(lf.x); ef.y = __builtin_amdgcn_exp2f(lf.y); kk[i] = 1.0f - ef; cum = cum + lf; bc[i] = cum; cv[i] = rv[i]; } \
        *(LAS f32x2*)(lds + H_TOT + (tg * 128 + 2 * kp) * 4) = cum; } while (0)
#define HG_WRITE(pb) do { \
        f32x2 off, blt; off.x = 0.f; off.y = 0.f; blt.x = 0.f; blt.y = 0.f; \
        _Pragma("unroll") for (int g2 = 0; g2 < 8; ++g2) { const f32x2 t = *(LAS f32x2*)(lds + H_TOT + (g2 * 128 + 2 * kp) * 4); if (g2 < tg) off = off + t; blt = blt + t; } \
        f32x2 kd[4]; \
        _Pragma("unroll") for (int i = 0; i < 4; ++i) { const int t = 4 * tg + i; const f32x2 b = bc[i] + off; \
            f32x2 e1, e2; e1.x = __builtin_amdgcn_exp2f(b.x); e1.y = __builtin_amdgcn_exp2f(b.y); e2.x = __builtin_amdgcn_exp2f(fminf(-b.x, 100.f)); e2.y = __builtin_amdgcn_exp2f(fminf(-b.y, 100.f)); \
            const f32x2 qi = qv[i] * e1; kd[i] = kk[i] * e2; \
            *(LAS unsigned*)(lds + (pb) + HB_QI + t * 272 + kp * 4) = pg8::cvt_pk_bf16(qi.x, qi.y); \
            *(LAS unsigned*)(lds + (pb) + HB_KD + t * 272 + kp * 4) = pg8::cvt_pk_bf16(kd[i].x, kd[i].y); } \
        { u32x2 w; w.x = pg8::cvt_pk_bf16(kd[0].x, kd[1].x); w.y = pg8::cvt_pk_bf16(kd[2].x, kd[3].x); *(LAS u32x2*)(lds + (pb) + HB_KT + (2 * kp) * 80 + tg * 8) = w; \
          w.x = pg8::cvt_pk_bf16(kd[0].y, kd[1].y); w.y = pg8::cvt_pk_bf16(kd[2].y, kd[3].y); *(LAS u32x2*)(lds + (pb) + HB_KT + (2 * kp + 1) * 80 + tg * 8) = w; } \
        if (tg == 0) { f32x2 e2; e2.x = __builtin_amdgcn_exp2f(blt.x); e2.y = __builtin_amdgcn_exp2f(blt.y); *(LAS f32x2*)(lds + (pb) + HB_E + (2 * kp) * 4) = e2; } \
        { u32x2 w; w.x = (unsigned)cv[0] | ((unsigned)cv[1] << 16); w.y = (unsigned)cv[2] | ((unsigned)cv[3] << 16); *(LAS u32x2*)(lds + (pb) + HB_VT + kp * 80 + tg * 8) = w; } } while (0)
    HG_LOAD(0); HG_FEAT(); HG_LOAD(1);
    LBAR();
    HG_WRITE(0);
    LBAR();
    for (int j = 0; j < 136; ++j) {
        const int pb = (j & 1) * HB_SZ;
        f32x16 o0, o1;
#pragma unroll
        for (int i = 0; i < 16; ++i) { o0[i] = 0.f; o1[i] = 0.f; }
        if (wave == 0) {
#pragma unroll
            for (int ks = 0; ks < 8; ks += 2) {
                const bf16x8 a = *(const LAS bf16x8*)(lds + pb + HB_KD + l31 * 272 + 32 * ks + 16 * hh), b = *(const LAS bf16x8*)(lds + pb + HB_QI + l31 * 272 + 32 * ks + 16 * hh);
                const bf16x8 a2 = *(const LAS bf16x8*)(lds + pb + HB_KD + l31 * 272 + 32 * (ks + 1) + 16 * hh), b2 = *(const LAS bf16x8*)(lds + pb + HB_QI + l31 * 272 + 32 * (ks + 1) + 16 * hh);
                o0 = MFMA32(a, b, o0); o1 = MFMA32(a2, b2, o1); }
        } else if (wave <= 2) {
            const int vi = wave - 1;
#pragma unroll
            for (int ks = 0; ks < 8; ks += 2) {
                const bf16x8 a = *(const LAS bf16x8*)(lds + pb + HB_QI + l31 * 272 + 32 * ks + 16 * hh), b = *(const LAS bf16x8*)(lds + H_ST + (32 * vi + l31) * 272 + 32 * ks + 16 * hh);
                const bf16x8 a2 = *(const LAS bf16x8*)(lds + pb + HB_QI + l31 * 272 + 32 * (ks + 1) + 16 * hh), b2 = *(const LAS bf16x8*)(lds + H_ST + (32 * vi + l31) * 272 + 32 * (ks + 1) + 16 * hh);
                o0 = MFMA32(a, b, o0); o1 = MFMA32(a2, b2, o1); }
        }
        { HG_FEAT(); const int jn = (j + 2 < 136) ? j + 2 : 135; HG_LOAD(jn); }
        if (wave == 0) {
#pragma unroll
            for (int gq = 0; gq < 4; ++gq) { const int s0 = 8 * gq + 4 * hh; float m[4];
#pragma unroll
                for (int e = 0; e < 4; ++e) m[e] = (s0 + e <= l31) ? (o0[4 * gq + e] + o1[4 * gq + e]) : 0.f;
                u32x2 w; w.x = pg8::cvt_pk_bf16(m[0], m[1]); w.y = pg8::cvt_pk_bf16(m[2], m[3]); *(LAS u32x2*)(lds + H_AM + l31 * 80 + s0 * 2) = w; }
        }
        LBAR();
        if (wave == 1 || wave == 2) {
            const int vi = wave - 1;
            { const bf16x8 a = *(const LAS bf16x8*)(lds + H_AM + l31 * 80 + 16 * hh), b = *(const LAS bf16x8*)(lds + pb + HB_VT + (32 * vi + l31) * 80 + 16 * hh); o0 = MFMA32(a, b, o0); }
            { const bf16x8 a = *(const LAS bf16x8*)(lds + H_AM + l31 * 80 + 32 + 16 * hh), b = *(const LAS bf16x8*)(lds + pb + HB_VT + (32 * vi + l31) * 80 + 32 + 16 * hh); o1 = MFMA32(a, b, o1); }
            HG_ROWS(j, rb, rs);
            GAS bf16_t* op = obase + 32 * vi + (rb + 4 * hh * rs) * D; const long ost = rs * D;
#pragma unroll
            for (int r = 0; r < 16; r += 2) { const int t = (r & 3) + 8 * (r >> 2); const unsigned w = pg8::cvt_pk_bf16(o0[r] + o1[r], o0[r + 1] + o1[r + 1]); op[t * ost] = (bf16_t)(w & 0xffffu); op[(t + 1) * ost] = (bf16_t)(w >> 16); }
        }
        { const int ki = wave & 3, vi2 = wave >> 2;
#pragma unroll
          for (int ks = 0; ks < 2; ++ks) { const bf16x8 a = *(const LAS bf16x8*)(lds + pb + HB_KT + (32 * ki + l31) * 80 + 32 * ks + 16 * hh), b = *(const LAS bf16x8*)(lds + pb + HB_VT + (32 * vi2 + l31) * 80 + 32 * ks + 16 * hh); Sacc = MFMA32(a, b, Sacc); }
#pragma unroll
          for (int gq = 0; gq < 4; ++gq) { const f32x4 e4 = *(const LAS f32x4*)(lds + pb + HB_E + (32 * ki + 8 * gq + 4 * hh) * 4);
#pragma unroll
              for (int e = 0; e < 4; ++e) Sacc[4 * gq + e] *= e4[e];
              u32x2 w; w.x = pg8::cvt_pk_bf16(Sacc[4 * gq], Sacc[4 * gq + 1]); w.y = pg8::cvt_pk_bf16(Sacc[4 * gq + 2], Sacc[4 * gq + 3]);
              *(LAS u32x2*)(lds + H_ST + (32 * vi2 + l31) * 272 + (32 * ki + 8 * gq + 4 * hh) * 2) = w; } }
        { const int pn = ((j + 1) & 1) * HB_SZ; HG_WRITE(pn); }
        LBAR();
    }
#undef HG_LOAD
#undef HG_FEAT
#undef HG_WRITE
#undef HG_ROWS
}

constexpr int RXB = 0, RXF = RXB + 128 * 144, RAA = RXF + 128 * 128, RBB = RAA + 128 * 128, RCAR = RBB + 128 * 128, RCARRY = RCAR + 16 * 32 * 8, REND = RCARRY + 256;
typedef float f32x4v __attribute__((ext_vector_type(4)));
#define MFMA16(a, b, c) __builtin_amdgcn_mfma_f32_16x16x32_bf16((a), (b), (c), 0, 0, 0)
__device__ __forceinline__ void rg_unit(const Ptrs& P, lptr lds, int l, int u) {
    const int tid = tid_opaque(), lane = tid & 63, wave = __builtin_amdgcn_readfirstlane(tid >> 6), l15 = lane & 15, q4 = lane >> 4;
    const int bl = u >> 5, head = (u >> 1) & 15, hf = u & 1;
    const int c0 = head * 64;
    const GAS bf16_t* Z = (const GAS bf16_t*)(P.ws + WS_Z);
    GAS bf16_t* R0 = (GAS bf16_t*)(P.ws + WS_R0);
    const int cp = tid & 31, tg = tid >> 5;
    float cwv[2][4], cbv[2];
#pragma unroll
    for (int e = 0; e < 2; ++e) { cbv[e] = P.rg_conv_b[l * 1024 + c0 + 2 * cp + e];
#pragma unroll
        for (int jj = 0; jj < 4; ++jj) cwv[e][jj] = P.rg_conv_w[(l * 4 + jj) * 1024 + c0 + 2 * cp + e]; }
    const int sc = tid & 31, sub = tid >> 5;
    const int mych = c0 + 32 * hf + sc;
    const GAS bf16_t* zx = Z + O_RGX + c0 + 2 * cp;
    const GAS bf16_t* zg = Z + O_RGG + mych;
    GAS bf16_t* rp = R0 + mych;
#pragma unroll
    for (int d = 0; d < 2; ++d) {
        bf16x8 wfa[2][2], wfx[2][2]; float c8l[2], bal[2], bxl[2];
#pragma unroll
        for (int nt = 0; nt < 2; ++nt) {
            const size_t wb = ((size_t)((l * 2 + d) * 16 + head) * 64) * 64 + 32 * hf + 16 * nt + l15;
            float fa[2][8], fx[2][8];
#pragma unroll
            for (int ks = 0; ks < 2; ++ks)
#pragma unroll
                for (int e = 0; e < 8; ++e) { const int i0 = 32 * ks + 8 * q4 + e; fa[ks][e] = P.rg_wa[wb + (size_t)i0 * 64]; fx[ks][e] = P.rg_wx[wb + (size_t)i0 * 64]; }
#pragma unroll
            for (int ks = 0; ks < 2; ++ks) { u32x4 t;
                t.x = pk2(fa[ks][0], fa[ks][1]); t.y = pk2(fa[ks][2], fa[ks][3]); t.z = pk2(fa[ks][4], fa[ks][5]); t.w = pk2(fa[ks][6], fa[ks][7]); wfa[nt][ks] = __builtin_bit_cast(bf16x8, t);
                t.x = pk2(fx[ks][0], fx[ks][1]); t.y = pk2(fx[ks][2], fx[ks][3]); t.z = pk2(fx[ks][4], fx[ks][5]); t.w = pk2(fx[ks][6], fx[ks][7]); wfx[nt][ks] = __builtin_bit_cast(bf16x8, t); }
            const int gch = (l * 2 + d) * 1024 + c0 + 32 * hf + 16 * nt + l15;
            c8l[nt] = 8.0f * 1.4426950408889634f * log1pf(expf(-P.rg_lam[gch]));
            bal[nt] = P.rg_ba[gch]; bxl[nt] = P.rg_bx[gch];
        }
#define RG_TILE(n, t0, rbase, len) int t0, len; long rbase; { const int _n = (n); if (_n < 2) { t0 = 128 * (d ? 1 - _n : _n); len = CTX; rbase = (long)bl * CTX; } else { t0 = 128 * (d ? 33 - _n : _n - 2); len = SEQ; rbase = (long)RC + (long)bl * SEQ; } }
        unsigned zr[11]; unsigned zvalid = 0u;
#define RG_LOAD(n) do { RG_TILE(n, _t0, _rb, _len); const int _ts = _t0 + 8 * tg - 1; const GAS bf16_t* _p = zx + (_rb + _ts) * INW; \
        _Pragma("unroll") for (int i = 0; i < 11; ++i) { const int _t = _ts + i; const int _tc = _t < 0 ? 0 : (_t >= _len ? _len - 1 : _t); zr[i] = *(const GAS unsigned*)(_p + (long)(_tc - _ts) * INW); } \
        zvalid = 0u; _Pragma("unroll") for (int i = 0; i < 11; ++i) { const int _t = _ts + i; if (_t >= 0 && _t < _len) zvalid |= (1u << i); } } while (0)
#define RG_CONV() do { _Pragma("unroll") for (int i = 0; i < 11; ++i) zr[i] = ((zvalid >> i) & 1u) ? zr[i] : 0u; \
        _Pragma("unroll") for (int i = 0; i < 8; ++i) { \
            const float x0 = cbv[0] + cwv[0][0] * bflo(zr[i]) + cwv[0][1] * bflo(zr[i + 1]) + cwv[0][2] * bflo(zr[i + 2]) + cwv[0][3] * bflo(zr[i + 3]); \
            const float x1 = cbv[1] + cwv[1][0] * bfhi(zr[i]) + cwv[1][1] * bfhi(zr[i + 1]) + cwv[1][2] * bfhi(zr[i + 2]) + cwv[1][3] * bfhi(zr[i + 3]); \
            const int tt = 8 * tg + i; *(LAS unsigned*)(lds + RXB + tt * 144 + cp * 4) = pg8::cvt_pk_bf16(x0, x1); \
            if ((cp >> 4) == hf) { f32x2 xx; xx.x = x0; xx.y = x1; *(LAS f32x2*)(lds + RXF + tt * 128 + (cp & 15) * 8) = xx; } } } while (0)
#define RG_GATES() do { f32x4v ga[2], gx[2]; _Pragma("unroll") for (int nt = 0; nt < 2; ++nt) { ga[nt] = (f32x4v){0.f, 0.f, 0.f, 0.f}; gx[nt] = (f32x4v){0.f, 0.f, 0.f, 0.f}; } \
        _Pragma("unroll") for (int ks = 0; ks < 2; ++ks) { const bf16x8 af = *(const LAS bf16x8*)(lds + RXB + (16 * wave + l15) * 144 + 64 * ks + 16 * q4); \
            _Pragma("unroll") for (int nt = 0; nt < 2; ++nt) { ga[nt] = MFMA16(af, wfa[nt][ks], ga[nt]); gx[nt] = MFMA16(af, wfx[nt][ks], gx[nt]); } } \
        _Pragma("unroll") for (int nt = 0; nt < 2; ++nt) _Pragma("unroll") for (int r = 0; r < 4; ++r) { const int tt = 16 * wave + 4 * q4 + r, cc = 16 * nt + l15; \
            const float xv = *(LAS float*)(lds + RXF + tt * 128 + cc * 4); \
            const float la = -c8l[nt] * sigm(ga[nt][r] + bal[nt]); const float av = __builtin_amdgcn_exp2f(la); \
            const float bv = __builtin_amdgcn_sqrtf(fmaxf(1.0f - av * av, 0.f)) * sigm(gx[nt][r] + bxl[nt]) * xv; \
            *(LAS float*)(lds + RAA + tt * 128 + cc * 4) = av; *(LAS float*)(lds + RBB + tt * 128 + cc * 4) = bv; } } while (0)
        LBAR();
        if (tid < 32) *(LAS float*)(lds + RCARRY + tid * 4) = 0.f;
        RG_LOAD(0); RG_CONV(); RG_LOAD(1);
        LBAR();
        RG_GATES();
        LBAR();
        for (int n = 0; n < 34; ++n) {
            RG_TILE(n, t0, rbase, len); (void)len;
            float av[8], bv[8]; float Pp = 1.f, Hl = 0.f;
#pragma unroll
            for (int ii = 0; ii < 8; ++ii) { const int i = d ? 7 - ii : ii; const int tt = 8 * sub + i;
                const float a = *(LAS float*)(lds + RAA + tt * 128 + sc * 4), b = *(LAS float*)(lds + RBB + tt * 128 + sc * 4);
                av[ii] = a; bv[ii] = b; Hl = a * Hl + b; Pp *= a; }
            { f32x2 ph; ph.x = Pp; ph.y = Hl; *(LAS f32x2*)(lds + RCAR + (sub * 32 + sc) * 8) = ph; }
            unsigned short gr[8], hr[8];
            if (d == 1) {
#pragma unroll
                for (int ii = 0; ii < 8; ++ii) { const long ro = rbase + t0 + 8 * sub + (7 - ii); gr[ii] = zg[ro * INW]; hr[ii] = rp[ro * D]; }
            }
            { RG_CONV(); const int nn = (n + 2 < 34) ? n + 2 : 33; RG_LOAD(nn); }
            LBAR();
            float hin = *(LAS float*)(lds + RCARRY + ((n & 1) * 32 + sc) * 4);
#pragma unroll
            for (int idx = 0; idx < 16; ++idx) { const int s2 = d ? 15 - idx : idx; const f32x2 ph = *(LAS f32x2*)(lds + RCAR + (s2 * 32 + sc) * 8);
                const bool use = d ? (s2 > sub) : (s2 < sub); hin = use ? ph.x * hin + ph.y : hin; }
            float outv[8];
#pragma unroll
            for (int ii = 0; ii < 8; ++ii) { hin = av[ii] * hin + bv[ii];
                if (d == 0) outv[ii] = hin;
                else { const float gg = bf1(gr[ii]); const float uu = 1.5957691216057308f * (gg + 0.044715f * gg * gg * gg);
                       outv[ii] = gg * sigm(uu) * (bf1(hr[ii]) + hin); } }
#pragma unroll
            for (int ii = 0; ii < 8; ii += 2) { const unsigned w = pg8::cvt_pk_bf16(outv[ii], outv[ii + 1]);
                const long ro0 = rbase + t0 + 8 * sub + (d ? 7 - ii : ii), ro1 = rbase + t0 + 8 * sub + (d ? 6 - ii : ii + 1);
                rp[ro0 * D] = (bf16_t)(w & 0xffffu); rp[ro1 * D] = (bf16_t)(w >> 16); }
            if ((d == 0 && sub == 15) || (d == 1 && sub == 0)) *(LAS float*)(lds + RCARRY + (((n + 1) & 1) * 32 + sc) * 4) = hin;
            { RG_GATES(); }
            LBAR();
        }
#undef RG_TILE
#undef RG_LOAD
#undef RG_CONV
#undef RG_GATES
    }
}

#define XB_TMO      128
#define XB_XCNT(j)  (256  + 64 * (j))
#define XB_XSUB(j)  (1280 + 64 * (j))
#define XB_XGEN(j)  (2304 + 64 * (j))
#define XB_TOP      3328
#define XB_TOPGEN   3392
#define XCD_BAR_WORDS 3456
#define XB_SPIN_CAP (1u << 18)

__device__ __forceinline__ unsigned xb_ld(unsigned* p)              { return __hip_atomic_load(p, __ATOMIC_RELAXED, __HIP_MEMORY_SCOPE_AGENT); }
__device__ __forceinline__ unsigned xb_add(unsigned* p, unsigned v) { return __hip_atomic_fetch_add(p, v, __ATOMIC_RELAXED, __HIP_MEMORY_SCOPE_AGENT); }
__device__ __forceinline__ unsigned xb_xcc_id() { return (unsigned)__builtin_amdgcn_s_getreg((3 << 11) | 20) & 0xFu; }
#define XB_SPIN(cond, bar) do { unsigned _sp = 0; while (cond) { __builtin_amdgcn_s_sleep(1); \
    if ((++_sp & 255u) == 0u) { if (xb_ld(&(bar)[XB_TMO])) break; if (_sp > XB_SPIN_CAP) { atomicAdd(&(bar)[XB_TMO], 1u); break; } } } } while (0)

struct XcdBarrier {
    unsigned* bar; unsigned x;
    volatile LAS unsigned* st;
};

__device__ __forceinline__ XcdBarrier xcd_barrier_post(unsigned* bar, volatile LAS unsigned* st) {
    XcdBarrier b; b.bar = bar; b.x = xb_xcc_id(); b.st = st;
    if (tid_opaque() == 0) (void)xb_add(&bar[XB_XCNT(b.x)], 1u);
    return b;
}
__device__ __forceinline__ void xcd_barrier_complete(unsigned* bar, unsigned x, unsigned& nloc, unsigned& nx) {
    const unsigned G = gridDim.x * gridDim.y * gridDim.z;
    unsigned sum, cnt, mine, sp = 0u;
    for (;;) {
        sum = 0u; cnt = 0u; mine = 0u;
#pragma unroll
        for (unsigned j = 0; j < 16; ++j) { const unsigned c = xb_ld(&bar[XB_XCNT(j)]); sum += c; cnt += (c > 0u) ? 1u : 0u; mine = (j == x) ? c : mine; }
        if (sum == G) break;
        __builtin_amdgcn_s_sleep(1);
        if ((++sp & 255u) == 0u) { if (xb_ld(&bar[XB_TMO])) break; if (sp > XB_SPIN_CAP) { atomicAdd(&bar[XB_TMO], 1u); break; } }
    }
    nloc = mine > 0u ? mine : 1u; nx = cnt > 0u ? cnt : 1u;
}

__device__ __forceinline__ void xcd_barrier(const XcdBarrier& b) {
    asm volatile("s_waitcnt vmcnt(0)" ::: "memory");
    __syncthreads();
    if (tid_opaque() == 0) {
        unsigned* bar = b.bar;
        __builtin_amdgcn_s_waitcnt(0);
        unsigned nloc = b.st[0], nx = b.st[1];
        if (nloc == 0u) { xcd_barrier_complete(bar, b.x, nloc, nx); b.st[0] = nloc; b.st[1] = nx; }
        const unsigned old = xb_add(&bar[XB_XSUB(b.x)], 1u);
        const unsigned gen = old / nloc;
        if (old + 1u == (gen + 1u) * nloc) {
            __builtin_amdgcn_fence(__ATOMIC_RELEASE, "agent");
            asm volatile("s_waitcnt vmcnt(0)" ::: "memory");
            const unsigned og = xb_add(&bar[XB_TOP], 1u);
            const unsigned tg = og / nx;
            if (og + 1u == (tg + 1u) * nx) xb_add(&bar[XB_TOPGEN], 1u);
            else XB_SPIN(xb_ld(&bar[XB_TOPGEN]) == tg, bar);
            __builtin_amdgcn_fence(__ATOMIC_ACQUIRE, "agent");
            xb_add(&bar[XB_XGEN(b.x)], 1u);
            asm volatile("s_waitcnt vmcnt(0)" ::: "memory");
        } else {
            XB_SPIN(xb_ld(&bar[XB_XGEN(b.x)]) == gen, bar);
            __builtin_amdgcn_fence(__ATOMIC_ACQUIRE, "agent");
            asm volatile("s_waitcnt vmcnt(0)" ::: "memory");
        }
    }
    __syncthreads();
}

struct Args { Ptrs p; int lo, hi; };
__global__ void __launch_bounds__(NTHREADS, 2) mega_fwd(Args args) {
    extern __shared__ __attribute__((aligned(16))) unsigned char lds_raw[];
    cg::grid_group grid = cg::this_grid();
    lptr lds = (lptr)lds_raw;
    const int lo = args.lo, hi = args.hi;
    typedef const Args __attribute__((address_space(4)))* kargp_t;
#define KP() ({ kargp_t _p = (kargp_t)__builtin_amdgcn_kernarg_segment_ptr(); asm volatile("" : "+s"(_p)); _p; })
#define GETP() Ptrs P; { kargp_t _kp = KP(); const unsigned long long* _src = (const unsigned long long*)_kp; unsigned long long* _dst = (unsigned long long*)&P; _Pragma("unroll") for (int _i = 0; _i < 29; ++_i) _dst[_i] = _src[_i]; } GAS unsigned char* ws = P.ws;
    int ph = 0;
    { volatile LAS unsigned* st0 = (volatile LAS unsigned*)(lds + XB_LDS_OFF); if (tid_opaque() < 2) st0[tid_opaque()] = 0u; }
    __syncthreads();
    XcdBarrier xbar = xcd_barrier_post((unsigned*)args.p.ws, (volatile LAS unsigned*)(lds + XB_LDS_OFF));
#define RUN (ph >= lo && ph < hi)
#define SEAM() do { ++ph; if (ph > lo && ph < hi) { if (lo < 0) grid.sync(); else xcd_barrier(xbar); } } while (0)
#define BUFS() GAS bf16_t* H = (GAS bf16_t*)(ws + WS_H); GAS bf16_t* R0 = (GAS bf16_t*)(ws + WS_R0); GAS bf16_t* OF = (GAS bf16_t*)(ws + WS_OF); GAS bf16_t* OB = (GAS bf16_t*)(ws + WS_OB); GAS bf16_t* Z = (GAS bf16_t*)(ws + WS_Z); GAS bf16_t* ACT = Z; (void)H; (void)R0; (void)OF; (void)OB; (void)ACT;
    const int G = gridDim.x, bid = blockIdx.x;

    if (RUN) { GETP(); BUFS(); mods_phase(P, lds); __syncthreads(); convert_weights(P, lds, 0); }
    SEAM();
    if (RUN) { GETP(); BUFS(); rowop_phase(P, 0, 0, 0); }
    SEAM();
    for (int g = 0; g < NGRP; ++g) {
        for (int l = 0; l < DEPTH; ++l) {
            const bool last = (l == DEPTH - 1);
            const int roff = last ? RC : 0, Mm = last ? RL : MG;
            if (RUN) { GETP(); BUFS(); pg8::Gemm gm{(const bf16_t*)(H), (const bf16_t*)(ws + WS_WIN), MG, INW, D}; EpiZ E{Z, (const GAS float*)(ws + WS_LB) + l * 1024};
                if (last) { pg8::LastLayerOrder S; S.init(RL, INW, RC / 256, G, bid); pg8::gemm_phase<EpiZ, pg8::LastLayerOrder>(lds, gm, S, E); }
                else { pg8::StaticOrder S; S.init(MG, INW, G, bid); pg8::gemm_phase<EpiZ, pg8::StaticOrder>(lds, gm, S, E); } }
            SEAM();
            if (RUN) { GETP(); BUFS(); const int vb = (G % 8 == 0) ? (bid % 8) * (G / 8) + bid / 8 : bid;
                       for (int u = vb; u < 256; u += G) hg_unit(P, lds, l, u);
                       for (int u = vb; u < 256; u += G) rg_unit(P, lds, l, u); }
            SEAM();
            if (RUN) { GETP(); BUFS(); pg8::StaticOrder S; S.init(Mm, D, G, bid);
                { pg8::Gemm gm{(const bf16_t*)(R0 + (size_t)roff * D), (const bf16_t*)(ws + WS_WPRG), Mm, D, D}; EpiGate<0> E{Z + O_GA, nullptr, H, roff}; pg8::gemm_phase<EpiGate<0>, pg8::StaticOrder>(lds, gm, S, E); }
                const int nun = (Mm / 256) * (D / 256); const int extra = (nun % G != 0 && G > 64) ? (nun % G) : 0;
                hgout_phase(P, l, extra <= G / 2 ? extra : 0); }
            SEAM();
            if (RUN) { GETP(); BUFS(); pg8::StaticOrder S; S.init(Mm, D, G, bid);
                { pg8::Gemm gm{(const bf16_t*)(OF + (size_t)roff * D), (const bf16_t*)(ws + WS_WPHG), Mm, D, D}; EpiGate<1> E{Z + O_GB, H, OB, roff}; pg8::gemm_phase<EpiGate<1>, pg8::StaticOrder>(lds, gm, S, E); } }
            SEAM();
            if (RUN) { GETP(); BUFS(); pg8::Gemm gm{(const bf16_t*)(OB + (size_t)roff * D), (const bf16_t*)(ws + WS_WOUT), Mm, D, D}; pg8::StaticOrder S; S.init(Mm, D, G, bid); EpiStore E{OF, D, roff}; pg8::gemm_phase<EpiStore, pg8::StaticOrder>(lds, gm, S, E); }
            SEAM();
            if (RUN) { GETP(); BUFS(); rowop_phase(P, 1, g, l); }
            SEAM();
            if (RUN) { GETP(); BUFS(); const int xoff = last ? RCX : 0, Mu = last ? RL : MGX;
                pg8::Gemm gm{(const bf16_t*)(H + (size_t)xoff * D), (const bf16_t*)(ws + WS_WUP), Mu, NUP, D}; pg8::StaticOrder S; S.init(Mu, NUP, G, bid);
                EpiUp E{ACT, P.ffn_conv_w + (size_t)l * 3 * DFF, P.ffn_conv_b + (size_t)l * DFF, last ? 10 : 0}; pg8::gemm_phase<EpiUp, pg8::StaticOrder>(lds, gm, S, E); }
            SEAM();
            if (RUN) { GETP(); BUFS(); pg8::Gemm gm{(const bf16_t*)(ACT + (size_t)roff * DFF), (const bf16_t*)(ws + WS_WDN), Mm, D, DFF}; pg8::StaticOrder S; S.init(Mm, D, G, bid); EpiStore E{OF, D, roff}; pg8::gemm_phase<EpiStore, pg8::StaticOrder>(lds, gm, S, E);
                const int nun = (Mm / 256) * (D / 256); const int extra = (nun % G != 0 && G > 64 && (nun % G) <= G / 2) ? (nun % G) : 0;
                LBAR();
                if (!last) convert_weights(P, lds, l + 1, 1, extra); else if (g + 1 < NGRP) convert_weights(P, lds, 0, 1, extra); }
            SEAM();
            if (RUN) { GETP(); BUFS(); rowop_phase(P, 2, g, l);
                if (!last) convert_weights(P, lds, l + 1, 2);
                else if (g + 1 < NGRP) { convert_weights(P, lds, 0, 2); rowop_phase(P, 0, g + 1, 0); } }
            SEAM();
        }
    }
#undef RUN
#undef SEAM
}
constexpr int N_PHASES = 2 + NGRP * DEPTH * 9;

extern "C" void kernel_launch(void* const* d_in, const int* in_sizes, int n_in, void* d_out, int out_size, void* d_ws, size_t ws_size, hipStream_t stream) {
    static int grid = 0;
    if (grid == 0) {
        if (n_in != 27 || ws_size < WS_END) { fprintf(stderr, "kernel_launch: unexpected n_in %d or ws_size %zu (< %zu)\n", n_in, ws_size, (size_t)WS_END); grid = -1; return; }
        int dev = 0, cus = 0, per_cu = 0;
        (void)hipGetDevice(&dev);
        (void)hipDeviceGetAttribute(&cus, hipDeviceAttributeMultiprocessorCount, dev);
        if (hipFuncSetAttribute((const void*)mega_fwd, hipFuncAttributeMaxDynamicSharedMemorySize, LDS_BYTES) != hipSuccess) { fprintf(stderr, "kernel_launch: hipFuncSetAttribute failed\n"); grid = -1; return; }
        if (hipOccupancyMaxActiveBlocksPerMultiprocessor(&per_cu, (const void*)mega_fwd, NTHREADS, LDS_BYTES) != hipSuccess || per_cu < 1) { fprintf(stderr, "kernel_launch: occupancy query says %d\n", per_cu); per_cu = 1; }
        (void)hipGetLastError();
        grid = cus * 1;
        fprintf(stderr, "kernel_launch: cus %d per_cu %d grid %d\n", cus, per_cu, grid);
    }
    if (grid < 0) return;
    if (hipMemsetAsync(d_ws, 0, 65536, stream) != hipSuccess) { fprintf(stderr, "kernel_launch: memset failed\n"); return; }
    Args a{};
    const GAS float** pp = (const GAS float**)&a.p;
    for (int i = 0; i < 27; ++i) pp[i] = (const GAS float*)d_in[i];
    a.p.out = (GAS float*)d_out; a.p.ws = (GAS unsigned char*)d_ws;
#ifdef MULTI_LAUNCH
    for (int p = 0; p < N_PHASES; ++p) { a.lo = p; a.hi = p + 1; hipLaunchKernelGGL(mega_fwd, dim3(grid), dim3(NTHREADS), LDS_BYTES, stream, a); }
#else
    a.lo = 0; a.hi = N_PHASES;
    void* kargs[] = {&a};
    hipError_t e = hipLaunchCooperativeKernel((void*)mega_fwd, dim3(grid), dim3(NTHREADS), kargs, LDS_BYTES, stream);
    if (e != hipSuccess) fprintf(stderr, "cooperative launch failed: %s (grid %d)\n", hipGetErrorString(e), grid);
#endif
}
```
